# Optimizing an MI355X kernel written in HIP

```python
import math
import jax, jax.numpy as jnp
from jax import lax
import numpy as np

D_MODEL = 1024
BATCH = 4
SEQ = 4096
DEPTH = 2

N_A = DEPTH // 2
N_B = DEPTH - N_A

D_FF = ((8 * D_MODEL // 3 + 127) // 128) * 128
FFN_RES_SCALE = 0.5

D_A = 2 * D_MODEL
CHUNK = 128
SGU_GROUPS = 8
SGU_GROUP_DIM = D_A // SGU_GROUPS

SB_HEADS = 16
SB_HEAD_DIM = D_MODEL // SB_HEADS
SB_KV_HEADS = 4
SB_GROUP = SB_HEADS // SB_KV_HEADS
Q_BLOCK = 128

NORM_EPS = 1e-6
LN_EPS = 1e-5

kernel_name = "yoco_gmlp_stickbreak_macaron"


def rms_norm(x, g):
    xf = x.astype(jnp.float32)
    y = xf * lax.rsqrt(jnp.mean(xf * xf, axis=-1, keepdims=True) + NORM_EPS)
    return (y * g.astype(jnp.float32)).astype(x.dtype)


def layer_norm(x, g, b):
    xf = x.astype(jnp.float32)
    mu = jnp.mean(xf, axis=-1, keepdims=True)
    xc = xf - mu
    var = jnp.mean(xc * xc, axis=-1, keepdims=True)
    y = xc * lax.rsqrt(var + LN_EPS) * g.astype(jnp.float32) + b.astype(jnp.float32)
    return y.astype(x.dtype)


def swiglu(h, w_in, w_out):
    gu = h @ w_in
    gate, up = jnp.split(gu, 2, axis=-1)
    return (jax.nn.silu(gate) * up) @ w_out


def chunked_sgu(h, w_in, ln_g, ln_b, w_s, b_s, w_out):
    B, S, _ = h.shape
    z = jax.nn.gelu(h @ w_in)
    u, v = jnp.split(z, 2, axis=-1)
    v = layer_norm(v, ln_g, ln_b)
    v = v.reshape(B, S // CHUNK, CHUNK, SGU_GROUPS, SGU_GROUP_DIM)
    causal = jnp.tril(jnp.ones((CHUNK, CHUNK), dtype=w_s.dtype))
    ws = w_s * causal[None]
    v = jnp.einsum('gts,bnsgc->bntgc', ws, v) + b_s.T[None, None, :, :, None]
    v = v.reshape(B, S, D_A)
    return (u * v) @ w_out


def stick_breaking_attention(q, k, v):
    B, S = q.shape[0], q.shape[1]
    nb = S // Q_BLOCK
    scale = 1.0 / math.sqrt(SB_HEAD_DIM)
    qf = (q.astype(jnp.float32) * scale).reshape(B, nb, Q_BLOCK, SB_KV_HEADS, SB_GROUP, SB_HEAD_DIM)
    qf = jnp.moveaxis(qf, 1, 0)
    kf = k.astype(jnp.float32)
    vf = v.astype(jnp.float32)
    key_pos = jnp.arange(S)

    def one_block(args):
        qb, bi = args
        q_pos = bi * Q_BLOCK + jnp.arange(Q_BLOCK)
        mask = key_pos[None, :] < q_pos[:, None]
        z = jnp.einsum('bqkgd,bskd->bkgqs', qb, kf)
        log_1m_beta = jnp.where(mask, jax.nn.log_sigmoid(-z), 0.0)
        rev = lax.cumsum(log_1m_beta, axis=4, reverse=True)
        excl = jnp.concatenate([rev[..., 1:], jnp.zeros_like(rev[..., :1])], axis=-1)
        a = jnp.where(mask, jnp.exp(jax.nn.log_sigmoid(z) + excl), 0.0)
        o = jnp.einsum('bkgqs,bskd->bqkgd', a, vf)
        return o.reshape(B, Q_BLOCK, SB_HEADS * SB_HEAD_DIM)

    o = lax.map(one_block, (qf, jnp.arange(nb)))
    o = jnp.moveaxis(o, 0, 1).reshape(B, S, SB_HEADS * SB_HEAD_DIM)
    return o.astype(q.dtype)


def setup_inputs(seed: int = 0) -> dict:
    key = jax.random.key(seed)
    ks = jax.random.split(key, 20)
    f32 = jnp.float32
    nrm = lambda k, shape, fan_in: jax.random.normal(k, shape, f32) * (fan_in ** -0.5)
    gain = lambda k, shape: 1.0 + 0.02 * jax.random.normal(k, shape, f32)
    HD = SB_HEADS * SB_HEAD_DIM
    KVD = SB_KV_HEADS * SB_HEAD_DIM
    return {
        "x": jax.random.normal(ks[0], (BATCH, SEQ, D_MODEL), f32),
        "ffn_norm": gain(ks[1], (DEPTH, 2, D_MODEL)),
        "ffn_w_in": nrm(ks[2], (DEPTH, 2, D_MODEL, 2 * D_FF), D_MODEL),
        "ffn_w_out": nrm(ks[3], (DEPTH, 2, D_FF, D_MODEL), D_FF),
        "mix_norm": gain(ks[4], (DEPTH, D_MODEL)),
        "a_w_in": nrm(ks[5], (N_A, D_MODEL, 2 * D_A), D_MODEL),
        "a_ln_g": gain(ks[6], (N_A, D_A)),
        "a_ln_b": 0.02 * jax.random.normal(ks[7], (N_A, D_A), f32),
        "a_w_s": 0.5 * nrm(ks[8], (N_A, SGU_GROUPS, CHUNK, CHUNK), CHUNK),
        "a_b_s": gain(ks[9], (N_A, SGU_GROUPS, CHUNK)),
        "a_w_out": nrm(ks[10], (N_A, D_A, D_MODEL), D_A),
        "kv_norm": gain(ks[11], (D_MODEL,)),
        "w_kv": nrm(ks[12], (D_MODEL, 2 * KVD), D_MODEL),
        "b_w_q": nrm(ks[13], (N_B, D_MODEL, HD), D_MODEL),
        "b_w_o": nrm(ks[14], (N_B, HD, D_MODEL), HD),
        "final_norm": gain(ks[15], (D_MODEL,)),
    }


def reference(x, ffn_norm, ffn_w_in, ffn_w_out, mix_norm, a_w_in, a_ln_g, a_ln_b, a_w_s,
              a_b_s, a_w_out, kv_norm, w_kv, b_w_q, b_w_o, final_norm):
    B, S, _ = x.shape
    k_shared = None
    v_shared = None
    for i in range(DEPTH):
        if i == N_A:
            kv = rms_norm(x, kv_norm) @ w_kv
            k_flat, v_flat = jnp.split(kv, 2, axis=-1)
            k_shared = k_flat.reshape(B, S, SB_KV_HEADS, SB_HEAD_DIM)
            v_shared = v_flat.reshape(B, S, SB_KV_HEADS, SB_HEAD_DIM)
        x = x + FFN_RES_SCALE * swiglu(rms_norm(x, ffn_norm[i, 0]), ffn_w_in[i, 0], ffn_w_out[i, 0])
        h = rms_norm(x, mix_norm[i])
        if i < N_A:
            x = x + chunked_sgu(h, a_w_in[i], a_ln_g[i], a_ln_b[i], a_w_s[i], a_b_s[i], a_w_out[i])
        else:
            j = i - N_A
            q = (h @ b_w_q[j]).reshape(B, S, SB_HEADS, SB_HEAD_DIM)
            x = x + stick_breaking_attention(q, k_shared, v_shared) @ b_w_o[j]
        x = x + FFN_RES_SCALE * swiglu(rms_norm(x, ffn_norm[i, 1]), ffn_w_in[i, 1], ffn_w_out[i, 1])
    return rms_norm(x, final_norm)
```

```cpp
#include <hip/hip_runtime.h>
#include <hip/hip_cooperative_groups.h>
#include <cstdio>
#include <cstdint>
namespace cg = cooperative_groups;
namespace pg8 {
#define PG8_LAS __attribute__((address_space(3)))
typedef unsigned short bf16_t;
typedef short bf16x8 __attribute__((ext_vector_type(8)));
typedef float f32x4 __attribute__((ext_vector_type(4)));
typedef unsigned u32x4 __attribute__((ext_vector_type(4)));
constexpr int BM = 256, BK = 64, HALF = 128, HTB = HALF * BK * 2  , STAGE_BYTES = 8 * HTB, NXCD = 8, WGM = 8;

__host__ __device__ __forceinline__ int lds_byte(int r, int c) { const int st = (r >> 4) * 2 + (c >> 5), rr = r & 15, cc = c & 31, ob = rr * 64 + cc * 2; return st * 1024 + (ob ^ (((ob >> 9) & 1) << 5)); }
__host__ __device__ __forceinline__ void stage_rc(int b, int& R, int& C) { const int st = b / 1024, sb = b % 1024, swz = sb ^ (((sb >> 9) & 1) << 5); R = (st >> 1) * 16 + swz / 64; C = (st & 1) * 32 + (swz % 64) / 2; }
__host__ __device__ __forceinline__ int perm32(int rho) { const int n = rho >> 4, i = rho & 15; return 8 * (i >> 2) + 4 * n + (i & 3); }

struct Unit { int pm, pn; };
struct Gemm { const bf16_t* A; const bf16_t* Bt; int M, N, K; };

struct StaticOrder {
    int nM, nN, nwg, G, c;
    __host__ __device__ void init(int M, int N, int G_, int c_) { nM = M / BM; nN = N / BM; nwg = nM * nN; G = G_; c = c_; }
    __host__ __device__ bool next(int i, Unit& u) const {
        const long L = (long)i * G + c; if (L >= nwg) return false;
        int wgid = (int)L; { const int q = nwg / NXCD, r = nwg % NXCD, xcd = wgid % NXCD, off = wgid / NXCD; wgid = (xcd < r ? xcd * (q + 1) : r * (q + 1) + (xcd - r) * q) + off; }
        const int nig = WGM * nN, gid = wgid / nig, fm = gid * WGM, gsz = (nM - fm) < WGM ? (nM - fm) : WGM;
        u.pm = fm + ((wgid % nig) % gsz); u.pn = (wgid % nig) / gsz; return true;
    }
    __device__ __forceinline__ void a_ready(const Unit&) const {}
    __device__ __forceinline__ void done(const Unit&) const {}
};

__device__ __forceinline__ unsigned cvt_pk_bf16(float lo, float hi) { unsigned r; asm volatile("v_cvt_pk_bf16_f32 %0, %1, %2" : "=v"(r) : "v"(lo), "v"(hi)); return r; }
typedef float f32x2 __attribute__((ext_vector_type(2)));
constexpr int EM = 16384, ED = 1024, EFF = 2816, EDA = 2048, ESEQ = 4096;
constexpr float RMS_EPS = 1e-6f;
__device__ __forceinline__ float silu_mul(float g, float u) { return g * u * __builtin_amdgcn_rcpf(1.f + __builtin_amdgcn_exp2f(-1.4426950409f * g)); }
__device__ __forceinline__ float gelu_tanh(float x) { const float t = x * (2.3022081f + 0.10294324f * x * x); return x * __builtin_amdgcn_rcpf(1.f + __builtin_amdgcn_exp2f(-t)); }
__device__ __forceinline__ float rstd_of(const float* ssq, int row) { return __builtin_amdgcn_rsqf(ssq[row] * (1.0f / 1024.0f) + RMS_EPS); }
__device__ __forceinline__ unsigned short bf16_1(float v) { return (unsigned short)(cvt_pk_bf16(v, 0.f) & 0xffffu); }

struct EpiSwiglu {
    static constexpr bool PERM = true, AFTER_DRAIN = false;
    bf16_t* H; const float* ssq; bf16_t* Kb; bf16_t* VT; int nffn;
    __device__ __forceinline__ void operator()(const f32x4 (&acc)[2][2][4][2], const Unit& u, int wr, int wc, int fr, int fq) const {
        const int row0 = u.pm * BM + wr * 64 + fr;
        if (u.pn < nffn) {
            const int col0 = u.pn * 128 + wc * 32 + 8 * fq;
#pragma unroll
            for (int ai = 0; ai < 2; ++ai)
#pragma unroll
                for (int m = 0; m < 4; ++m) { const int row = row0 + ai * HALF + m * 16; const float rs = rstd_of(ssq, row);
                    const f32x4 g0 = acc[ai][0][m][0] * rs, g1 = acc[ai][0][m][1] * rs, u0 = acc[ai][1][m][0] * rs, u1 = acc[ai][1][m][1] * rs;
                    u32x4 w; w.x = cvt_pk_bf16(silu_mul(g0[0], u0[0]), silu_mul(g0[1], u0[1])); w.y = cvt_pk_bf16(silu_mul(g0[2], u0[2]), silu_mul(g0[3], u0[3]));
                    w.z = cvt_pk_bf16(silu_mul(g1[0], u1[0]), silu_mul(g1[1], u1[1])); w.w = cvt_pk_bf16(silu_mul(g1[2], u1[2]), silu_mul(g1[3], u1[3]));
                    *(u32x4*)(H + (size_t)row * EFF + col0) = w; }
        } else {
            const int isv = u.pn - nffn;
#pragma unroll
            for (int ai = 0; ai < 2; ++ai)
#pragma unroll
                for (int m = 0; m < 4; ++m) { const int row = row0 + ai * HALF + m * 16; const float rs = rstd_of(ssq, row);
#pragma unroll
                    for (int bj = 0; bj < 2; ++bj) { const int col = bj * HALF + wc * 32 + 8 * fq; const f32x4 v0 = acc[ai][bj][m][0] * rs, v1 = acc[ai][bj][m][1] * rs;
                        if (isv == 0) { u32x4 w; w.x = cvt_pk_bf16(v0[0], v0[1]); w.y = cvt_pk_bf16(v0[2], v0[3]); w.z = cvt_pk_bf16(v1[0], v1[1]); w.w = cvt_pk_bf16(v1[2], v1[3]);
                            *(u32x4*)(Kb + (size_t)row * 256 + col) = w; }
                        else { const int b = row >> 12, s = row & (ESEQ - 1), kvh = col >> 6, d0 = col & 63;
                            bf16_t* p = VT + ((size_t)((b * 4 + kvh) * 64 + d0)) * ESEQ + s;
#pragma unroll
                            for (int e = 0; e < 4; ++e) { p[(size_t)e * ESEQ] = bf16_1(v0[e]); p[(size_t)(e + 4) * ESEQ] = bf16_1(v1[e]); } } } }
        }
    }
};
struct EpiResid {
    static constexpr bool PERM = true, AFTER_DRAIN = false;
    const float* src; float* dst; bf16_t* xb; float* ssq_out; float scale;
    __device__ __forceinline__ void operator()(const f32x4 (&acc)[2][2][4][2], const Unit& u, int wr, int wc, int fr, int fq) const {
        const int row0 = u.pm * BM + wr * 64 + fr, col0 = u.pn * BM + wc * 32 + 8 * fq;
#pragma unroll
        for (int ai = 0; ai < 2; ++ai)
#pragma unroll
            for (int m = 0; m < 4; ++m) { const int row = row0 + ai * HALF + m * 16; float ss = 0.f;
#pragma unroll
                for (int bj = 0; bj < 2; ++bj) { const size_t off = (size_t)row * ED + col0 + bj * HALF;
                    const f32x4 a0 = *(const f32x4*)(src + off), a1 = *(const f32x4*)(src + off + 4);
                    const f32x4 v0 = a0 + acc[ai][bj][m][0] * scale, v1 = a1 + acc[ai][bj][m][1] * scale;
                    *(f32x4*)(dst + off) = v0; *(f32x4*)(dst + off + 4) = v1;
                    ss += (v0[0] * v0[0] + v0[1] * v0[1]) + (v0[2] * v0[2] + v0[3] * v0[3]) + (v1[0] * v1[0] + v1[1] * v1[1]) + (v1[2] * v1[2] + v1[3] * v1[3]);
                    u32x4 w; w.x = cvt_pk_bf16(v0[0], v0[1]); w.y = cvt_pk_bf16(v0[2], v0[3]); w.z = cvt_pk_bf16(v1[0], v1[1]); w.w = cvt_pk_bf16(v1[2], v1[3]);
                    *(u32x4*)(xb + off) = w; }
                ss += __shfl_xor(ss, 16); ss += __shfl_xor(ss, 32);
                if (fq == 0) unsafeAtomicAdd(ssq_out + row, ss);
                if (m & 1) asm volatile("" ::: "memory"); }
    }
};
template <int ACT> struct EpiRowScale {
    static constexpr bool PERM = true, AFTER_DRAIN = false;
    bf16_t* O; int ldc; const float* ssq; float oscale;
    __device__ __forceinline__ void operator()(const f32x4 (&acc)[2][2][4][2], const Unit& u, int wr, int wc, int fr, int fq) const {
        const int row0 = u.pm * BM + wr * 64 + fr, col0 = u.pn * BM + wc * 32 + 8 * fq;
#pragma unroll
        for (int ai = 0; ai < 2; ++ai)
#pragma unroll
            for (int m = 0; m < 4; ++m) { const int row = row0 + ai * HALF + m * 16; const float rs = rstd_of(ssq, row);
#pragma unroll
                for (int bj = 0; bj < 2; ++bj) { f32x4 v0 = acc[ai][bj][m][0] * rs, v1 = acc[ai][bj][m][1] * rs;
                    if (ACT == 1) {
#pragma unroll
                        for (int e = 0; e < 4; ++e) { v0[e] = gelu_tanh(v0[e]); v1[e] = gelu_tanh(v1[e]); } }
                    v0 = v0 * oscale; v1 = v1 * oscale;
                    u32x4 w; w.x = cvt_pk_bf16(v0[0], v0[1]); w.y = cvt_pk_bf16(v0[2], v0[3]); w.z = cvt_pk_bf16(v1[0], v1[1]); w.w = cvt_pk_bf16(v1[2], v1[3]);
                    *(u32x4*)(O + (size_t)row * ldc + col0 + bj * HALF) = w; } }
    }
};
struct EpiGeluVT {
    static constexpr bool PERM = true, AFTER_DRAIN = false;
    bf16_t* VT; const float* ssq; float* vsum; float* vsq;
    __device__ __forceinline__ void operator()(const f32x4 (&acc)[2][2][4][2], const Unit& u, int wr, int wc, int fr, int fq) const {
        const int row0 = u.pm * BM + wr * 64 + fr, col0 = u.pn * BM + wc * 32 + 8 * fq;
#pragma unroll
        for (int bj = 0; bj < 2; ++bj) {
            float rs[8], cs[8], cq[8];
#pragma unroll
            for (int e = 0; e < 8; ++e) { rs[e] = rstd_of(ssq, col0 + bj * HALF + e); cs[e] = 0.f; cq[e] = 0.f; }
#pragma unroll
            for (int ai = 0; ai < 2; ++ai)
#pragma unroll
                for (int m = 0; m < 4; ++m) { const int row = row0 + ai * HALF + m * 16; float v[8];
#pragma unroll
                    for (int e = 0; e < 4; ++e) { v[e] = gelu_tanh(acc[ai][bj][m][0][e] * rs[e]); v[e + 4] = gelu_tanh(acc[ai][bj][m][1][e] * rs[e + 4]); }
#pragma unroll
                    for (int e = 0; e < 8; ++e) { cs[e] += v[e]; cq[e] += v[e] * v[e]; }
                    u32x4 w; w.x = cvt_pk_bf16(v[0], v[1]); w.y = cvt_pk_bf16(v[2], v[3]); w.z = cvt_pk_bf16(v[4], v[5]); w.w = cvt_pk_bf16(v[6], v[7]);
                    *(u32x4*)(VT + (size_t)row * EM + col0 + bj * HALF) = w; }
#pragma unroll
            for (int e = 0; e < 8; ++e) {
#pragma unroll
                for (int o = 1; o < 16; o <<= 1) { cs[e] += __shfl_xor(cs[e], o); cq[e] += __shfl_xor(cq[e], o); } }
            if (fr == 0) {
#pragma unroll
                for (int e = 0; e < 8; ++e) { unsafeAtomicAdd(vsum + col0 + bj * HALF + e, cs[e]); unsafeAtomicAdd(vsq + col0 + bj * HALF + e, cq[e]); } }
        }
    }
};

template <class Epi, class Sched, bool ALIGN_EPI = false, bool SP2 = false>
__device__ __forceinline__ void gemm_phase(PG8_LAS unsigned char* lds, const Gemm g, const Sched& S, const Epi& E) {
    const int tid = threadIdx.x, wid = __builtin_amdgcn_readfirstlane(tid >> 6), lane = tid & 63, wr = wid >> 2, wc = wid & 3, fr = lane & 15, fq = lane >> 4;
    const int K = g.K, nt = K / BK;
    unsigned voffA[2], voffB[2];
#pragma unroll
    for (int i = 0; i < 2; ++i) { int R, C; stage_rc(tid * 16 + i * 8192, R, C); const int Rb = Epi::PERM ? ((R & ~31) + perm32(R & 31)) : R;
        voffA[i] = (unsigned)(R * K + C) * 2u; voffB[i] = (unsigned)(Rb * K + C) * 2u; }
    const size_t kstep = (size_t)(BK * 2);
    const size_t hstep = (size_t)HALF * K * 2;
    const size_t tstep = 2 * hstep;
    const unsigned ldsw = (unsigned)wid * 1024u;
    const int aoff = lds_byte(wr * 64 + fr, fq * 8), boff = lds_byte(wc * 32 + fr, fq * 8);
#define PG8_SA(b, h) (((b) * 2 + (h)) * HTB)
#define PG8_SB(b, h) ((4 + (b) * 2 + (h)) * HTB)
#define PG8_STAGE(bufoff, gbase, voff) do { _Pragma("unroll") for (int _i = 0; _i < 2; ++_i) \
        __builtin_amdgcn_global_load_lds((const unsigned*)((const char*)(gbase) + (voff)[_i]), (PG8_LAS unsigned*)(lds + (bufoff) + ldsw + _i * 8192), 16, 0, 0); } while (0)
#define PG8_LDA(dst, b, h) do { _Pragma("unroll") for (int m = 0; m < 4; ++m) _Pragma("unroll") for (int k = 0; k < 2; ++k) dst[m][k] = *(const PG8_LAS bf16x8*)(lds + PG8_SA(b, h) + aoff + m * 2048 + k * 1024); } while (0)
#define PG8_LDB(dst, b, h) do { _Pragma("unroll") for (int n = 0; n < 2; ++n) _Pragma("unroll") for (int k = 0; k < 2; ++k) dst[n][k] = *(const PG8_LAS bf16x8*)(lds + PG8_SB(b, h) + boff + n * 2048 + k * 1024); } while (0)
#define PG8_MMA(ai, bj, At, Bt) do { __builtin_amdgcn_s_setprio(1); _Pragma("unroll") for (int m = 0; m < 4; ++m) _Pragma("unroll") for (int n = 0; n < 2; ++n) _Pragma("unroll") for (int k = 0; k < 2; ++k) \
        acc[ai][bj][m][n] = __builtin_amdgcn_mfma_f32_16x16x32_bf16(Bt[n][k], At[m][k], acc[ai][bj][m][n], 0, 0, 0); __builtin_amdgcn_s_setprio(0); } while (0)
#define PG8_WAIT_V(n) asm volatile("s_waitcnt vmcnt(" #n ")" ::: "memory")
#define PG8_WAIT_L(n) asm volatile("s_waitcnt lgkmcnt(" #n ")" ::: "memory")
#define PG8_BAR __builtin_amdgcn_s_barrier()
#define PG8_SCHED __builtin_amdgcn_sched_barrier(0)
    Unit cur, nxt; int ui = 0;
    if (!S.next(0, cur)) return;
    f32x4 acc[2][2][4][2];
#pragma unroll
    for (int a = 0; a < 2; ++a)
#pragma unroll
        for (int b = 0; b < 2; ++b)
#pragma unroll
            for (int m = 0; m < 4; ++m)
#pragma unroll
                for (int n = 0; n < 2; ++n) acc[a][b][m][n] = (f32x4){0.f, 0.f, 0.f, 0.f};
    bf16x8 At[4][2], B0[2][2], B1[2][2];
    const char* cA = (const char*)g.A + (size_t)cur.pm * tstep; const char* cB = (const char*)g.Bt + (size_t)cur.pn * tstep;
    S.a_ready(cur);
    if constexpr (SP2) {
        PG8_STAGE(PG8_SB(0, 0), cB, voffB); PG8_STAGE(PG8_SB(0, 1), cB + hstep, voffB); PG8_STAGE(PG8_SA(0, 0), cA, voffA); PG8_STAGE(PG8_SA(0, 1), cA + hstep, voffA);
        if (wr == 1) PG8_BAR;
        PG8_WAIT_V(2); PG8_BAR;
        PG8_STAGE(PG8_SB(1, 0), cB + kstep, voffB); PG8_STAGE(PG8_SA(1, 0), cA + kstep, voffA); PG8_STAGE(PG8_SB(1, 1), cB + hstep + kstep, voffB);
        PG8_WAIT_V(6); PG8_BAR;
    } else {
        PG8_STAGE(PG8_SB(0, 0), cB, voffB); PG8_STAGE(PG8_SA(0, 0), cA, voffA); PG8_STAGE(PG8_SB(0, 1), cB + hstep, voffB); PG8_STAGE(PG8_SA(0, 1), cA + hstep, voffA);
        if (wr == 1) PG8_BAR;
        PG8_WAIT_V(4); PG8_BAR;
        PG8_STAGE(PG8_SB(1, 0), cB + kstep, voffB); PG8_STAGE(PG8_SA(1, 0), cA + kstep, voffA); PG8_STAGE(PG8_SB(1, 1), cB + hstep + kstep, voffB);
        PG8_WAIT_V(6); PG8_BAR;
    }
    for (;;) {
        const bool has_next = S.next(ui + 1, nxt);
        const char* nA = has_next ? (const char*)g.A + (size_t)nxt.pm * tstep : cA; const char* nB = has_next ? (const char*)g.Bt + (size_t)nxt.pn * tstep : cB;
        for (int t = 0; t < nt; t += 2) {
            const bool last = (t == nt - 2);
            const char* a1 = cA + (size_t)(t + 1) * kstep;
            const char* a2 = last ? nA : cA + (size_t)(t + 2) * kstep; const char* b2 = last ? nB : cB + (size_t)(t + 2) * kstep;
            const char* a3 = a2 + kstep; const char* b3 = b2 + kstep;
            if (last && has_next) S.a_ready(nxt);
            if constexpr (SP2) {
            PG8_LDB(B0, 0, 0); PG8_LDB(B1, 0, 1); PG8_SCHED; PG8_LDA(At, 0, 0); PG8_STAGE(PG8_SA(1, 1), a1 + hstep, voffA);
            PG8_WAIT_V(8); PG8_WAIT_L(0); PG8_BAR; PG8_MMA(0, 0, At, B0); PG8_MMA(0, 1, At, B1); PG8_BAR; PG8_SCHED;
            PG8_LDA(At, 0, 1); PG8_STAGE(PG8_SB(0, 0), b2, voffB); PG8_STAGE(PG8_SB(0, 1), b2 + hstep, voffB); PG8_STAGE(PG8_SA(0, 0), a2, voffA);
            PG8_WAIT_V(8); PG8_WAIT_L(0); PG8_BAR; PG8_MMA(1, 0, At, B0); PG8_MMA(1, 1, At, B1); PG8_BAR; PG8_SCHED;
            PG8_LDB(B0, 1, 0); PG8_LDB(B1, 1, 1); PG8_SCHED; PG8_LDA(At, 1, 0); PG8_STAGE(PG8_SA(0, 1), a2 + hstep, voffA);
            PG8_WAIT_V(8); PG8_WAIT_L(0); PG8_BAR; PG8_MMA(0, 0, At, B0); PG8_MMA(0, 1, At, B1); PG8_BAR; PG8_SCHED;
            PG8_LDA(At, 1, 1); PG8_STAGE(PG8_SB(1, 0), b3, voffB); PG8_STAGE(PG8_SB(1, 1), b3 + hstep, voffB); PG8_STAGE(PG8_SA(1, 0), a3, voffA);
            PG8_WAIT_V(8); PG8_WAIT_L(0); PG8_BAR; PG8_MMA(1, 0, At, B0); PG8_MMA(1, 1, At, B1); PG8_BAR; PG8_SCHED;
            } else {
            PG8_LDB(B0, 0, 0); PG8_SCHED; PG8_LDA(At, 0, 0); PG8_STAGE(PG8_SA(1, 1), a1 + hstep, voffA);
            PG8_WAIT_L(8); PG8_BAR; PG8_WAIT_L(0); PG8_MMA(0, 0, At, B0); PG8_BAR; PG8_SCHED;
            PG8_LDB(B1, 0, 1); PG8_STAGE(PG8_SB(0, 0), b2, voffB);
            PG8_BAR; PG8_WAIT_L(0); PG8_MMA(0, 1, At, B1); PG8_BAR;
            PG8_LDA(At, 0, 1); PG8_STAGE(PG8_SA(0, 0), a2, voffA);
            PG8_BAR; PG8_WAIT_L(0); PG8_MMA(1, 0, At, B0); PG8_BAR; PG8_SCHED;
            PG8_STAGE(PG8_SB(0, 1), b2 + hstep, voffB);
            PG8_WAIT_V(6); PG8_BAR; PG8_MMA(1, 1, At, B1); PG8_BAR;
            PG8_LDB(B0, 1, 0); PG8_SCHED; PG8_LDA(At, 1, 0); PG8_STAGE(PG8_SA(0, 1), a2 + hstep, voffA);
            PG8_WAIT_L(8); PG8_BAR; PG8_WAIT_L(0); PG8_MMA(0, 0, At, B0); PG8_BAR; PG8_SCHED;
            PG8_LDB(B1, 1, 1); PG8_STAGE(PG8_SB(1, 0), b3, voffB);
            PG8_BAR; PG8_WAIT_L(0); PG8_MMA(0, 1, At, B1); PG8_BAR;
            PG8_LDA(At, 1, 1); PG8_STAGE(PG8_SA(1, 0), a3, voffA);
            PG8_BAR; PG8_WAIT_L(0); PG8_MMA(1, 0, At, B0); PG8_BAR; PG8_SCHED;
            PG8_STAGE(PG8_SB(1, 1), b3 + hstep, voffB);
            PG8_WAIT_V(6); PG8_BAR; PG8_MMA(1, 1, At, B1); PG8_BAR;
            }
        }
        if constexpr (ALIGN_EPI) { if (wr == 0) PG8_BAR; }
        if constexpr (!Epi::AFTER_DRAIN) { E(acc, cur, wr, wc, fr, fq); S.done(cur); }
        if (!has_next) break;
#pragma unroll
        for (int a = 0; a < 2; ++a)
#pragma unroll
            for (int b = 0; b < 2; ++b)
#pragma unroll
                for (int m = 0; m < 4; ++m)
#pragma unroll
                    for (int n = 0; n < 2; ++n) acc[a][b][m][n] = (f32x4){0.f, 0.f, 0.f, 0.f};
        cur = nxt; cA = nA; cB = nB; ++ui;
        if constexpr (ALIGN_EPI) { if (wr == 1) PG8_BAR; }
    }
    PG8_WAIT_V(0);
    if constexpr (!ALIGN_EPI) { if (wr == 0) PG8_BAR; }
    PG8_BAR;
    if constexpr (Epi::AFTER_DRAIN) { E.fused(acc, cur, wr, wc, fr, fq, lds, wid, lane); S.done(cur); }
#undef PG8_SA
#undef PG8_SB
#undef PG8_STAGE
#undef PG8_LDA
#undef PG8_LDB
#undef PG8_MMA
#undef PG8_WAIT_V
#undef PG8_WAIT_L
#undef PG8_BAR
#undef PG8_SCHED
}
}
constexpr int NWAVES = 8;
constexpr int M = 16384, D = 1024, DFF = 2816, DA = 2048, SEQ = 4096, NBATCH = 4;
constexpr int NIN_FFN = 2 * DFF;
constexpr int NIN_KV = NIN_FFN + 512;
#ifndef MK_PER_PHASE
#define MK_PER_PHASE 0
#endif
constexpr int N_PHASES = 16;

constexpr size_t MiB = 1u << 20;
constexpr size_t WS_CTL = 0, CTL_ZERO_BYTES = 1 * MiB;
constexpr size_t WS_WIN = 2 * MiB;
constexpr size_t WIN_STRIDE = 12 * MiB;
constexpr size_t WS_WOUT = WS_WIN + 4 * WIN_STRIDE;
constexpr size_t WOUT_STRIDE = 6 * MiB;
constexpr size_t WS_AIN = WS_WOUT + 4 * WOUT_STRIDE;
constexpr size_t WS_AOUT = WS_AIN + 8 * MiB;
constexpr size_t WS_WQ = WS_AOUT + 4 * MiB;
constexpr size_t WS_WO = WS_WQ + 2 * MiB;
constexpr size_t WS_XB = WS_WO + 2 * MiB;
constexpr size_t WS_H = WS_XB + 32 * MiB;
constexpr size_t WS_R2 = WS_H + 88 * MiB;
constexpr size_t WS_END = WS_R2 + 64 * MiB;
constexpr int CW_BAR = 4096;
constexpr int CW_SSQ = 16384;
constexpr int CW_VSUM = CW_SSQ + 7 * M, CW_VSQ = CW_VSUM + M;
static_assert((size_t)(CW_VSQ + M) * 4 <= CTL_ZERO_BYTES, "CTL words inside the memset region");

constexpr int RING_OFF = 0, RING_BYTES = 131072;
constexpr int LDSCTL_OFF = RING_BYTES, MISC_OFF = LDSCTL_OFF + 320;
constexpr int LDS_BYTES = 147456;

#define GAS __attribute__((address_space(1)))
#define LAS __attribute__((address_space(3)))
typedef unsigned short bf16;
typedef unsigned v4u __attribute__((ext_vector_type(4)));
typedef float f32x4 __attribute__((ext_vector_type(4)));
typedef short bf16x8 __attribute__((ext_vector_type(8)));
typedef GAS unsigned gu32;
typedef GAS unsigned long long gu64;
#define RLX_AGENT __ATOMIC_RELAXED, __HIP_MEMORY_SCOPE_AGENT
#define LDS_WAIT() asm volatile("s_waitcnt lgkmcnt(0)" ::: "memory")
#define VM_WAIT() asm volatile("s_waitcnt vmcnt(0)" ::: "memory")
__device__ __forceinline__ unsigned long long rt() { return __builtin_amdgcn_s_memrealtime(); }
__device__ __forceinline__ unsigned f2bf(float f) { unsigned u = __builtin_bit_cast(unsigned, f); return (u + 0x7fffu + ((u >> 16) & 1u)) >> 16; }
__device__ __forceinline__ unsigned pk2(float lo, float hi) { return f2bf(lo) | (f2bf(hi) << 16); }

#define XB_TMO      128
#define XB_XCNT(j)  (256  + 64 * (j))
#define XB_XSUB(j)  (1280 + 64 * (j))
#define XB_XGEN(j)  (2304 + 64 * (j))
#define XB_TOP      3328
#define XB_TOPGEN   3392
#define XCD_BAR_WORDS 3456
#define XB_SPIN_CAP (1u << 18)

__device__ __forceinline__ unsigned xb_ld(unsigned* p)              { return __hip_atomic_load(p, __ATOMIC_RELAXED, __HIP_MEMORY_SCOPE_AGENT); }
__device__ __forceinline__ unsigned xb_add(unsigned* p, unsigned v) { return __hip_atomic_fetch_add(p, v, __ATOMIC_RELAXED, __HIP_MEMORY_SCOPE_AGENT); }
__device__ __forceinline__ unsigned xb_xcc_id() { return (unsigned)__builtin_amdgcn_s_getreg((3 << 11) | 20) & 0xFu; }
#define XB_SPIN(cond, bar) do { unsigned _sp = 0; while (cond) { __builtin_amdgcn_s_sleep(1); \
    if ((++_sp & 255u) == 0u) { if (xb_ld(&(bar)[XB_TMO])) break; if (_sp > XB_SPIN_CAP) { atomicAdd(&(bar)[XB_TMO], 1u); break; } } } } while (0)

struct XcdBarrier {
    unsigned* bar; unsigned x;
    volatile LAS unsigned* st;
};

__device__ __forceinline__ XcdBarrier xcd_barrier_post(unsigned* bar, volatile LAS unsigned* st) {
    XcdBarrier b; b.bar = bar; b.x = xb_xcc_id(); b.st = st;
    if (threadIdx.x == 0) (void)xb_add(&bar[XB_XCNT(b.x)], 1u);
    return b;
}
__device__ __forceinline__ void xcd_barrier_complete(unsigned* bar, unsigned x, unsigned& nloc, unsigned& nx) {
    const unsigned G = gridDim.x * gridDim.y * gridDim.z;
    unsigned sum, cnt, mine, sp = 0u;
    for (;;) {
        sum = 0u; cnt = 0u; mine = 0u;
#pragma unroll
        for (unsigned j = 0; j < 16; ++j) { const unsigned c = xb_ld(&bar[XB_XCNT(j)]); sum += c; cnt += (c > 0u) ? 1u : 0u; mine = (j == x) ? c : mine; }
        if (sum == G) break;
        __builtin_amdgcn_s_sleep(1);
        if ((++sp & 255u) == 0u) { if (xb_ld(&bar[XB_TMO])) break; if (sp > XB_SPIN_CAP) { atomicAdd(&bar[XB_TMO], 1u); break; } }
    }
    nloc = mine > 0u ? mine : 1u; nx = cnt > 0u ? cnt : 1u;
}

__device__ __forceinline__ void xcd_barrier(const XcdBarrier& b) {
    asm volatile("s_waitcnt vmcnt(0)" ::: "memory");
    __syncthreads();
    if (threadIdx.x == 0) {
        unsigned* bar = b.bar;
        __builtin_amdgcn_s_waitcnt(0);
        unsigned nloc = b.st[0], nx = b.st[1];
        if (nloc == 0u) { xcd_barrier_complete(bar, b.x, nloc, nx); b.st[0] = nloc; b.st[1] = nx; }
        const unsigned old = xb_add(&bar[XB_XSUB(b.x)], 1u);
        const unsigned gen = old / nloc;
        if (old + 1u == (gen + 1u) * nloc) {
            __builtin_amdgcn_fence(__ATOMIC_RELEASE, "agent");
            asm volatile("s_waitcnt vmcnt(0)" ::: "memory");
            const unsigned og = xb_add(&bar[XB_TOP], 1u);
            const unsigned tg = og / nx;
            if (og + 1u == (tg + 1u) * nx) xb_add(&bar[XB_TOPGEN], 1u);
            else XB_SPIN(xb_ld(&bar[XB_TOPGEN]) == tg, bar);
            __builtin_amdgcn_fence(__ATOMIC_ACQUIRE, "agent");
            xb_add(&bar[XB_XGEN(b.x)], 1u);
            asm volatile("s_waitcnt vmcnt(0)" ::: "memory");
        } else {
            XB_SPIN(xb_ld(&bar[XB_XGEN(b.x)]) == gen, bar);
            __builtin_amdgcn_fence(__ATOMIC_ACQUIRE, "agent");
            asm volatile("s_waitcnt vmcnt(0)" ::: "memory");
        }
    }
    __syncthreads();
}
typedef float f32x16 __attribute__((ext_vector_type(16)));
typedef short s16x4 __attribute__((ext_vector_type(4)));
typedef unsigned v2u __attribute__((ext_vector_type(2)));
typedef float f32x2_t __attribute__((ext_vector_type(2))); typedef __bf16 bf16x2_t __attribute__((ext_vector_type(2)));
__device__ __forceinline__ unsigned cvtpk(float lo, float hi) { f32x2_t v = {lo, hi}; bf16x2_t b = __builtin_convertvector(v, bf16x2_t); return __builtin_bit_cast(unsigned, b); }
__device__ __forceinline__ float bflo(unsigned w) { return __uint_as_float(w << 16); }
__device__ __forceinline__ float bfhi(unsigned w) { return __uint_as_float(w & 0xffff0000u); }

struct Frame {
    LAS unsigned char* lds;
    volatile LAS unsigned* MISC;
    gu32* ctl;
    int tid, lane, wave;
    int vcu, G;
};
__device__ __forceinline__ float wave_sum(float v) {
#pragma unroll
    for (int o = 1; o < 64; o <<= 1) v += __shfl_xor(v, o);
    return v;
}
__device__ __forceinline__ void p0_item(const float* W, int ldn, int K, int nblk, bf16* WT, const float* gk, int mode, LAS float* scr, int item, int lane) {
    const int kb = item / nblk, nb = item % nblk, k0 = 64 * kb, n0 = 32 * nb;
    const int rowb = (mode == 0) ? n0 : (256 * (n0 >> 7) + (n0 & 127) + (mode == 2 ? 128 : 0));
#pragma unroll 8
    for (int i = 0; i < 32; ++i) { const int kk = 2 * i + (lane >> 5); float w = W[(size_t)(k0 + kk) * ldn + n0 + (lane & 31)]; if (gk) w *= gk[k0 + kk]; scr[kk * 33 + (lane & 31)] = w; }
    LDS_WAIT(); asm volatile("" ::: "memory");
    const int c = lane & 7;
#pragma unroll
    for (int j = 0; j < 4; ++j) { const int n = (lane >> 3) + 8 * j; const LAS float* s = scr + (8 * c) * 33 + n;
        v4u o; o.x = pk2(s[0 * 33], s[1 * 33]); o.y = pk2(s[2 * 33], s[3 * 33]); o.z = pk2(s[4 * 33], s[5 * 33]); o.w = pk2(s[6 * 33], s[7 * 33]);
        *(GAS v4u*)(WT + (size_t)(rowb + n) * K + k0 + 8 * c) = o; }
    LDS_WAIT(); asm volatile("" ::: "memory");
}
struct Ptrs {
    const float *x, *ffn_norm, *ffn_w_in, *ffn_w_out, *mix_norm, *a_w_in, *a_ln_g, *a_ln_b, *a_w_s, *a_b_s, *a_w_out, *kv_norm, *w_kv, *b_w_q, *b_w_o, *final_norm;
    float* X;
    bf16 *WIN, *WOUT, *AIN, *AOUT, *WQ, *WO, *XB, *H, *U, *VTs, *Q, *Kb, *VTa;
    float *ssq, *vsum, *vsq;
};
__device__ __forceinline__ void p0_prologue(Frame& F, const Ptrs& P) {
    LAS float* scr = (LAS float*)(F.lds + RING_OFF + F.wave * 16384);
    const int gw = F.vcu * NWAVES + F.wave, NGW = F.G * NWAVES;
    constexpr int I_IN = 16 * (DFF / 32);
    constexpr int I_KV = 16 * (512 / 32);
    constexpr int I_OUT = (DFF / 64) * (D / 32);
    constexpr int I_AIN = 16 * (2 * DA / 32);
    constexpr int I_AOUT = (DA / 64) * (D / 32);
    constexpr int I_Q = 16 * 32;
    constexpr int NITEMS = 8 * I_IN + I_KV + 4 * I_OUT + I_AIN + I_AOUT + 2 * I_Q;
    for (int it = gw; it < NITEMS; it += NGW) {
        int r = it;
        if (r < 8 * I_IN) { const int mat = r / (2 * I_IN), rr = r % (2 * I_IN), up = rr / I_IN, item = rr % I_IN;
            p0_item(P.ffn_w_in + (size_t)mat * D * NIN_FFN + up * DFF, NIN_FFN, D, DFF / 32, (bf16*)((char*)P.WIN + mat * WIN_STRIDE), P.ffn_norm + mat * D, 1 + up, scr, item, F.lane); continue; }
        r -= 8 * I_IN;
        if (r < I_KV) { p0_item(P.w_kv, 512, D, 16, (bf16*)((char*)P.WIN + 2 * WIN_STRIDE) + (size_t)NIN_FFN * D, P.kv_norm, 0, scr, r, F.lane); continue; }
        r -= I_KV;
        if (r < 4 * I_OUT) { const int mat = r / I_OUT, item = r % I_OUT;
            p0_item(P.ffn_w_out + (size_t)mat * DFF * D, D, DFF, D / 32, (bf16*)((char*)P.WOUT + mat * WOUT_STRIDE), nullptr, 0, scr, item, F.lane); continue; }
        r -= 4 * I_OUT;
        if (r < I_AIN) { p0_item(P.a_w_in, 2 * DA, D, 2 * DA / 32, P.AIN, P.mix_norm, 0, scr, r, F.lane); continue; }
        r -= I_AIN;
        if (r < I_AOUT) { p0_item(P.a_w_out, D, DA, D / 32, P.AOUT, nullptr, 0, scr, r, F.lane); continue; }
        r -= I_AOUT;
        if (r < I_Q) { p0_item(P.b_w_q, D, D, D / 32, P.WQ, P.mix_norm + D, 0, scr, r, F.lane); continue; }
        r -= I_Q;
        p0_item(P.b_w_o, D, D, D / 32, P.WO, nullptr, 0, scr, r, F.lane);
    }
    for (int m = gw; m < M; m += NGW) {
        const GAS f32x4* xr = (const GAS f32x4*)(P.x + (size_t)m * D) + F.lane;
        f32x4 v[4]; float s = 0.f;
#pragma unroll
        for (int j = 0; j < 4; ++j) { v[j] = xr[64 * j]; s += (v[j].x * v[j].x + v[j].y * v[j].y) + (v[j].z * v[j].z + v[j].w * v[j].w); }
        s = wave_sum(s);
        GAS unsigned long long* o8 = (GAS unsigned long long*)(P.XB + (size_t)m * D) + F.lane;
#pragma unroll
        for (int j = 0; j < 4; ++j) o8[64 * j] = (unsigned long long)pk2(v[j].x, v[j].y) | ((unsigned long long)pk2(v[j].z, v[j].w) << 32);
        if (F.lane == 0) P.ssq[m] = s;
    }
}
__device__ __forceinline__ void final_norm_phase(Frame& F, const Ptrs& P) {
    const int gw = F.vcu * NWAVES + F.wave, NGW = F.G * NWAVES;
    f32x4 g[4];
#pragma unroll
    for (int j = 0; j < 4; ++j) g[j] = ((const GAS f32x4*)P.final_norm)[F.lane + 64 * j];
    for (int m = gw; m < M; m += NGW) {
        GAS f32x4* xr = (GAS f32x4*)(P.X + (size_t)m * D) + F.lane;
        const float rs = __builtin_amdgcn_rsqf(P.ssq[6 * M + m] * (1.0f / 1024.0f) + 1e-6f);
#pragma unroll
        for (int j = 0; j < 4; ++j) { const f32x4 v = xr[64 * j]; xr[64 * j] = v * rs * g[j]; }
    }
}

constexpr int SG_WM = 0, SG_LD = 272, SG_BT = 128 * SG_LD  , SG_CLD = 528, SG_STAT = SG_BT + 256 * SG_LD  ;
static_assert(128 * SG_CLD <= 256 * SG_LD && SG_STAT + 1024 <= RING_BYTES, "sgu LDS map");
__device__ __forceinline__ void sgu_phase(Frame& F, const Ptrs& P) {
    LAS unsigned char* lds = F.lds + RING_OFF;
    const int tid = F.tid, lane = F.lane, wid = F.wave, fr = lane & 15, fq = lane >> 4, wt = wid >> 2, wc = wid & 3;
    int gload = -1;
    for (int un = F.vcu; un < 1024; un += F.G) {
        const int g = un & 7, chunk = un >> 3, tok0 = chunk * 128;
        __syncthreads();
        if (g != gload) {
            const float* ws = P.a_w_s + (size_t)g * 128 * 128;
#pragma unroll
            for (int i = 0; i < 4; ++i) { const int idx = i * 512 + tid, t = idx >> 4, s8 = (idx & 15) * 8;
                const f32x4 a = *(const GAS f32x4*)(ws + t * 128 + s8), b = *(const GAS f32x4*)(ws + t * 128 + s8 + 4);
                float v[8] = {a.x, a.y, a.z, a.w, b.x, b.y, b.z, b.w};
#pragma unroll
                for (int e = 0; e < 8; ++e) v[e] = (s8 + e <= t) ? v[e] : 0.f;
                v4u o; o.x = cvtpk(v[0], v[1]); o.y = cvtpk(v[2], v[3]); o.z = cvtpk(v[4], v[5]); o.w = cvtpk(v[6], v[7]);
                *(LAS v4u*)(lds + SG_WM + t * SG_LD + s8 * 2) = o; }
            gload = g;
        }
        if (tid < 128) { const float sm = P.vsum[tok0 + tid], sq = P.vsq[tok0 + tid]; const float mean = sm * (1.0f / 2048.0f);
            const float var = fmaxf(sq * (1.0f / 2048.0f) - mean * mean, 0.f);
            ((LAS float*)(lds + SG_STAT))[tid] = mean; ((LAS float*)(lds + SG_STAT))[128 + tid] = __builtin_amdgcn_rsqf(var + 1e-5f); }
        __syncthreads();
        {
            const int s8 = (tid & 15) * 8; float mu[8], rsd[8];
#pragma unroll
            for (int e = 0; e < 8; ++e) { mu[e] = ((LAS float*)(lds + SG_STAT))[s8 + e]; rsd[e] = ((LAS float*)(lds + SG_STAT))[128 + s8 + e]; }
#pragma unroll
            for (int i = 0; i < 8; ++i) { const int c = i * 32 + (tid >> 4), cgl = g * 256 + c;
                const v4u w = *(const GAS v4u*)(P.VTs + (size_t)cgl * M + tok0 + s8); const float lg = P.a_ln_g[cgl], lb = P.a_ln_b[cgl];
                float v[8] = {bflo(w.x), bfhi(w.x), bflo(w.y), bfhi(w.y), bflo(w.z), bfhi(w.z), bflo(w.w), bfhi(w.w)};
#pragma unroll
                for (int e = 0; e < 8; ++e) v[e] = (v[e] - mu[e]) * rsd[e] * lg + lb;
                v4u o; o.x = cvtpk(v[0], v[1]); o.y = cvtpk(v[2], v[3]); o.z = cvtpk(v[4], v[5]); o.w = cvtpk(v[6], v[7]);
                *(LAS v4u*)(lds + SG_BT + c * SG_LD + s8 * 2) = o; }
        }
        __syncthreads();
        f32x4 acc[4][4];
#pragma unroll
        for (int a = 0; a < 4; ++a)
#pragma unroll
            for (int b = 0; b < 4; ++b) acc[a][b] = (f32x4){0.f, 0.f, 0.f, 0.f};
#pragma unroll
        for (int ks = 0; ks < 4; ++ks) { bf16x8 af[4], bfr[4];
#pragma unroll
            for (int i = 0; i < 4; ++i) { af[i] = *(const LAS bf16x8*)(lds + SG_WM + (wt * 64 + i * 16 + fr) * SG_LD + (ks * 32 + fq * 8) * 2);
                                          bfr[i] = *(const LAS bf16x8*)(lds + SG_BT + (wc * 64 + i * 16 + fr) * SG_LD + (ks * 32 + fq * 8) * 2); }
#pragma unroll
            for (int mt = 0; mt < 4; ++mt)
#pragma unroll
                for (int nt = 0; nt < 4; ++nt) acc[mt][nt] = __builtin_amdgcn_mfma_f32_16x16x32_bf16(bfr[nt], af[mt], acc[mt][nt], 0, 0, 0); }
        __syncthreads();
#pragma unroll
        for (int mt = 0; mt < 4; ++mt) { const int t = wt * 64 + mt * 16 + fr; const float bs = P.a_b_s[g * 128 + t];
#pragma unroll
            for (int nt = 0; nt < 4; ++nt) { const int c = wc * 64 + nt * 16 + 4 * fq; const f32x4 v = acc[mt][nt] + bs;
                v2u o; o.x = cvtpk(v[0], v[1]); o.y = cvtpk(v[2], v[3]); *(LAS v2u*)(lds + SG_BT + t * SG_CLD + c * 2) = o; } }
        __syncthreads();
#pragma unroll
        for (int i = 0; i < 8; ++i) { const int idx = i * 512 + tid, t = idx >> 5, c8 = (idx & 31) * 8;
            const v4u cw = *(const LAS v4u*)(lds + SG_BT + t * SG_CLD + c8 * 2);
            GAS v4u* up = (GAS v4u*)(P.U + (size_t)(tok0 + t) * DA + g * 256 + c8); const v4u uw = *up;
            v4u o; o.x = cvtpk(bflo(cw.x) * bflo(uw.x), bfhi(cw.x) * bfhi(uw.x)); o.y = cvtpk(bflo(cw.y) * bflo(uw.y), bfhi(cw.y) * bfhi(uw.y));
            o.z = cvtpk(bflo(cw.z) * bflo(uw.z), bfhi(cw.z) * bfhi(uw.z)); o.w = cvtpk(bflo(cw.w) * bflo(uw.w), bfhi(cw.w) * bfhi(uw.w));
            *up = o; }
    }
    __syncthreads();
}

constexpr int AT_K = 0, AT_KLD = 144, AT_V = 64 * AT_KLD  , AT_VLD = 136, AT_FLAG = AT_V + 64 * AT_VLD  ;
constexpr float SB_DONE = -150.0f;
__device__ __forceinline__ int crow(int r, int hi) { return (r & 3) + 8 * (r >> 2) + 4 * hi; }
template <bool MASKED> __device__ __forceinline__ void sb_block(f32x16& p, float& carry, int hi, int qloc, unsigned (&pk)[8]) {
    float l[16];
#pragma unroll
    for (int i = 0; i < 16; ++i) { const float z = p[i]; const float sp = fmaxf(z, 0.f) + __builtin_amdgcn_logf(1.f + __builtin_amdgcn_exp2f(-fabsf(z)));
        l[i] = -sp; if (MASKED) { if (!(crow(i, hi) < qloc)) l[i] = 0.f; } }
    float gs[4], pg[4];
#pragma unroll
    for (int g = 0; g < 4; ++g) gs[g] = (l[4 * g] + l[4 * g + 1]) + (l[4 * g + 2] + l[4 * g + 3]);
#pragma unroll
    for (int g = 0; g < 4; ++g) pg[g] = __shfl_xor(gs[g], 32);
    const float t0 = gs[0] + pg[0], t1 = gs[1] + pg[1], t2 = gs[2] + pg[2], t3 = gs[3] + pg[3];
    float above[4]; above[3] = 0.f; above[2] = t3; above[1] = t3 + t2; above[0] = t3 + t2 + t1;
    const float total = above[0] + t0;
#pragma unroll
    for (int g = 0; g < 4; ++g) { float c = carry + above[g] + (hi == 0 ? pg[g] : 0.f);
#pragma unroll
        for (int e = 3; e >= 0; --e) { const int i = 4 * g + e; c += l[i]; float a = __builtin_amdgcn_exp2f(p[i] + c); if (MASKED) { if (!(crow(i, hi) < qloc)) a = 0.f; } p[i] = a; } }
    carry += total;
#pragma unroll
    for (int j = 0; j < 8; ++j) pk[j] = cvtpk(p[2 * j], p[2 * j + 1]);
}
__device__ __forceinline__ void attn_phase(Frame& F, const Ptrs& P) {
    LAS unsigned char* lds = F.lds + RING_OFF;
    volatile LAS unsigned* flag = (volatile LAS unsigned*)(lds + AT_FLAG);
    const int tid = F.tid, lane = F.lane, wid = F.wave, r32 = lane & 31, hi = lane >> 5, half = wid & 1;
    for (int un = F.vcu; un < 1024; un += F.G) {
        const int bk = un & 15, qb = un >> 4, b = bk >> 2, kvh = bk & 3, hq = kvh * 4 + (wid >> 1);
        const size_t qrow = (size_t)b * SEQ + qb * 64 + half * 32 + r32;
        bf16x8 qr[4];
#pragma unroll
        for (int d0 = 0; d0 < 4; ++d0) qr[d0] = *(const GAS bf16x8*)(P.Q + qrow * D + hq * 64 + d0 * 16 + hi * 8);
        f32x16 o0, o1;
#pragma unroll
        for (int i = 0; i < 16; ++i) { o0[i] = 0.f; o1[i] = 0.f; }
        float carry = 0.f; bool active = true; int it = 0;
        for (int kt = qb; kt >= 0; --kt, ++it) {
            __syncthreads();
            if (it > 0) { if (flag[(it - 1) & 1] == 0u) break; }
            if (tid == 0) flag[it & 1] = 0u;
            {
                const int r = tid >> 3, c8 = (tid & 7) * 8;
                const v4u kw = *(const GAS v4u*)(P.Kb + ((size_t)b * SEQ + kt * 64 + r) * 256 + kvh * 64 + c8);
                const v4u vw = *(const GAS v4u*)(P.VTa + ((size_t)(bk * 64 + r)) * SEQ + kt * 64 + c8);
                *(LAS v4u*)(lds + AT_K + r * AT_KLD + c8 * 2) = kw;
                *(LAS v2u*)(lds + AT_V + r * AT_VLD + c8 * 2) = (v2u){vw.x, vw.y}; *(LAS v2u*)(lds + AT_V + r * AT_VLD + c8 * 2 + 8) = (v2u){vw.z, vw.w};
            }
            __syncthreads();
            if (active) {
                const bool diag = (kt == qb);
#pragma unroll
                for (int blk = 1; blk >= 0; --blk) {
                    if (diag && blk > half) continue;
                    f32x16 p;
#pragma unroll
                    for (int i = 0; i < 16; ++i) p[i] = 0.f;
#pragma unroll
                    for (int d0 = 0; d0 < 4; ++d0) { const bf16x8 kf = *(const LAS bf16x8*)(lds + AT_K + (blk * 32 + r32) * AT_KLD + (d0 * 16 + hi * 8) * 2);
                        p = __builtin_amdgcn_mfma_f32_32x32x16_bf16(kf, qr[d0], p, 0, 0, 0); }
                    unsigned pk[8];
                    if (diag && blk == half) sb_block<true>(p, carry, hi, r32, pk); else sb_block<false>(p, carry, hi, r32, pk);
#pragma unroll
                    for (int s = 0; s < 2; ++s) { const bf16x8 pf = __builtin_bit_cast(bf16x8, (v4u){pk[4 * s], pk[4 * s + 1], pk[4 * s + 2], pk[4 * s + 3]});
#pragma unroll
                        for (int db = 0; db < 2; ++db) { const LAS unsigned char* vp = lds + AT_V + (db * 32 + r32) * AT_VLD + (blk * 32 + 16 * s + 4 * hi) * 2;
                            const v2u lo = *(const LAS v2u*)vp, hh = *(const LAS v2u*)(vp + 16);
                            const bf16x8 vf = __builtin_bit_cast(bf16x8, (v4u){lo.x, lo.y, hh.x, hh.y});
                            if (db == 0) o0 = __builtin_amdgcn_mfma_f32_32x32x16_bf16(vf, pf, o0, 0, 0, 0); else o1 = __builtin_amdgcn_mfma_f32_32x32x16_bf16(vf, pf, o1, 0, 0, 0); } }
                }
                if (__any(carry > SB_DONE)) { if (lane == 0) flag[it & 1] = 1u; } else active = false;
            }
        }
        bf16* op = P.Q + qrow * D + hq * 64;
#pragma unroll
        for (int g = 0; g < 4; ++g) { v2u w0, w1; w0.x = cvtpk(o0[4 * g], o0[4 * g + 1]); w0.y = cvtpk(o0[4 * g + 2], o0[4 * g + 3]); w1.x = cvtpk(o1[4 * g], o1[4 * g + 1]); w1.y = cvtpk(o1[4 * g + 2], o1[4 * g + 3]);
            *(GAS v2u*)(op + 8 * g + 4 * hi) = w0; *(GAS v2u*)(op + 32 + 8 * g + 4 * hi) = w1; }
    }
    __syncthreads();
}

struct Args { const float* in[16]; float* out; unsigned char* ws; int ph_lo, ph_hi; };
__global__ void __launch_bounds__(NWAVES * 64, 2) yoco_fwd(Args args) {
    extern __shared__ __attribute__((aligned(16))) unsigned char lds[];
    Frame F;
    F.lds = (LAS unsigned char*)lds;
    F.MISC = (volatile LAS unsigned*)(F.lds + MISC_OFF);
    F.tid = threadIdx.x; F.lane = F.tid & 63; F.wave = __builtin_amdgcn_readfirstlane(F.tid >> 6);
    F.G = gridDim.x; { const int bx = blockIdx.x; F.vcu = (F.G % 8 == 0) ? (bx % 8) * (F.G / 8) + bx / 8 : bx; }
    unsigned char* ws = args.ws;
    F.ctl = (gu32*)(ws + WS_CTL);
    Ptrs P;
    P.x = args.in[0]; P.ffn_norm = args.in[1]; P.ffn_w_in = args.in[2]; P.ffn_w_out = args.in[3]; P.mix_norm = args.in[4]; P.a_w_in = args.in[5]; P.a_ln_g = args.in[6]; P.a_ln_b = args.in[7];
    P.a_w_s = args.in[8]; P.a_b_s = args.in[9]; P.a_w_out = args.in[10]; P.kv_norm = args.in[11]; P.w_kv = args.in[12]; P.b_w_q = args.in[13]; P.b_w_o = args.in[14]; P.final_norm = args.in[15];
    P.X = args.out;
    P.WIN = (bf16*)(ws + WS_WIN); P.WOUT = (bf16*)(ws + WS_WOUT); P.AIN = (bf16*)(ws + WS_AIN); P.AOUT = (bf16*)(ws + WS_AOUT); P.WQ = (bf16*)(ws + WS_WQ); P.WO = (bf16*)(ws + WS_WO);
    P.XB = (bf16*)(ws + WS_XB); P.H = (bf16*)(ws + WS_H); P.U = (bf16*)(ws + WS_H); P.VTs = (bf16*)(ws + WS_R2);
    P.Q = (bf16*)(ws + WS_R2); P.Kb = (bf16*)(ws + WS_R2 + 32 * MiB); P.VTa = (bf16*)(ws + WS_R2 + 40 * MiB);
    P.ssq = (float*)(ws + WS_CTL) + CW_SSQ; P.vsum = (float*)(ws + WS_CTL) + CW_VSUM; P.vsq = (float*)(ws + WS_CTL) + CW_VSQ;
    for (int u = F.tid; u < (LDS_BYTES - LDSCTL_OFF) / 4; u += NWAVES * 64) ((LAS unsigned*)(F.lds + LDSCTL_OFF))[u] = 0u;
    __syncthreads();
    XcdBarrier bar; bar.bar = (unsigned*)(F.ctl + CW_BAR); bar.x = 0; bar.st = nullptr;
#if !MK_PER_PHASE
    bar = xcd_barrier_post((unsigned*)(F.ctl + CW_BAR), F.MISC + 8);
#endif
    const int lo = args.ph_lo, hi = args.ph_hi;
#define IN(k) (lo <= (k) && (k) < hi)
#if MK_PER_PHASE
#define SEAM(k) do { } while (0)
#define SEAM_CG(k) do { } while (0)
#else
#define SEAM(k) do { if (IN(k) && IN((k) + 1)) xcd_barrier(bar); } while (0)
#define SEAM_CG(k) do { if (IN(k) && IN((k) + 1)) { asm volatile("s_waitcnt vmcnt(0)" ::: "memory"); __threadfence(); cg::this_grid().sync(); } } while (0)
#endif
    using pg8::Gemm; using pg8::StaticOrder;
    LAS unsigned char* ring = F.lds + RING_OFF;
    const int bid = (int)blockIdx.x;
#define WINp(mat) ((const pg8::bf16_t*)((const char*)P.WIN + (size_t)(mat) * WIN_STRIDE))
#define WOUTp(mat) ((const pg8::bf16_t*)((const char*)P.WOUT + (size_t)(mat) * WOUT_STRIDE))
#define FFN_IN(mat, nn, ssqi) do { Gemm g{(const pg8::bf16_t*)P.XB, WINp(mat), M, (nn), D}; StaticOrder S; S.init(M, (nn), F.G, bid); \
        pg8::EpiSwiglu E{(pg8::bf16_t*)P.H, P.ssq + (ssqi) * M, (pg8::bf16_t*)P.Kb, (pg8::bf16_t*)P.VTa, NIN_FFN / 256}; \
        pg8::gemm_phase<pg8::EpiSwiglu, StaticOrder, true, true>(ring, g, S, E); } while (0)
#define FFN_OUT(mat, srcp, ssqo) do { Gemm g{(const pg8::bf16_t*)P.H, WOUTp(mat), M, D, DFF}; StaticOrder S; S.init(M, D, F.G, bid); \
        pg8::EpiResid E{(srcp), P.X, (pg8::bf16_t*)P.XB, P.ssq + (ssqo) * M, 0.5f}; \
        pg8::gemm_phase<pg8::EpiResid, StaticOrder, true, true>(ring, g, S, E); } while (0)

    if (IN(0)) { p0_prologue(F, P); } SEAM_CG(0);
    if (IN(1)) { FFN_IN(0, NIN_FFN, 0); } SEAM(1);
    if (IN(2)) { FFN_OUT(0, P.x, 1); } SEAM(2);
    if (IN(3)) {
        { Gemm g{(const pg8::bf16_t*)P.XB, (const pg8::bf16_t*)P.AIN, M, DA, D}; StaticOrder S; S.init(M, DA, F.G, bid);
          pg8::EpiRowScale<1> E{(pg8::bf16_t*)P.U, DA, P.ssq + 1 * M, 1.0f};
          pg8::gemm_phase<pg8::EpiRowScale<1>, StaticOrder, true, true>(ring, g, S, E); }
        { Gemm g{(const pg8::bf16_t*)P.AIN + (size_t)DA * D, (const pg8::bf16_t*)P.XB, DA, M, D}; StaticOrder S; S.init(DA, M, F.G, bid);
          pg8::EpiGeluVT E{(pg8::bf16_t*)P.VTs, P.ssq + 1 * M, P.vsum, P.vsq};
          pg8::gemm_phase<pg8::EpiGeluVT, StaticOrder, true, true>(ring, g, S, E); }
    } SEAM(3);
    if (IN(4)) { sgu_phase(F, P); } SEAM(4);
    if (IN(5)) { Gemm g{(const pg8::bf16_t*)P.U, (const pg8::bf16_t*)P.AOUT, M, D, DA}; StaticOrder S; S.init(M, D, F.G, bid);
        pg8::EpiResid E{P.X, P.X, (pg8::bf16_t*)P.XB, P.ssq + 2 * M, 1.0f};
        pg8::gemm_phase<pg8::EpiResid, StaticOrder, true, true>(ring, g, S, E); } SEAM(5);
    if (IN(6)) { FFN_IN(1, NIN_FFN, 2); } SEAM(6);
    if (IN(7)) { FFN_OUT(1, P.X, 3); } SEAM(7);
    if (IN(8)) { FFN_IN(2, NIN_KV, 3); } SEAM(8);
    if (IN(9)) { FFN_OUT(2, P.X, 4); } SEAM(9);
    if (IN(10)) { Gemm g{(const pg8::bf16_t*)P.XB, (const pg8::bf16_t*)P.WQ, M, D, D}; StaticOrder S; S.init(M, D, F.G, bid);
        pg8::EpiRowScale<0> E{(pg8::bf16_t*)P.Q, D, P.ssq + 4 * M, 0.125f * 1.4426950409f};
        pg8::gemm_phase<pg8::EpiRowScale<0>, StaticOrder, true, true>(ring, g, S, E); } SEAM(10);
    if (IN(11)) { attn_phase(F, P); } SEAM(11);
    if (IN(12)) { Gemm g{(const pg8::bf16_t*)P.Q, (const pg8::bf16_t*)P.WO, M, D, D}; StaticOrder S; S.init(M, D, F.G, bid);
        pg8::EpiResid E{P.X, P.X, (pg8::bf16_t*)P.XB, P.ssq + 5 * M, 1.0f};
        pg8::gemm_phase<pg8::EpiResid, StaticOrder, true, true>(ring, g, S, E); } SEAM(12);
    if (IN(13)) { FFN_IN(3, NIN_FFN, 5); } SEAM(13);
    if (IN(14)) { FFN_OUT(3, P.X, 6); } SEAM(14);
    if (IN(15)) { final_norm_phase(F, P); }
#undef IN
}

extern "C" void kernel_launch(void* const* d_in, const int* in_sizes, int n_in, void* d_out, int out_size, void* d_ws, size_t ws_size, hipStream_t stream) {
    static int grid = 0;
    if (grid == 0) {
        if (n_in != 16 || in_sizes[0] != M * D || out_size != M * D || ws_size < WS_END) { fprintf(stderr, "kernel_launch: unexpected shapes / workspace (n_in %d, in0 %d, out %d, ws %zu); nothing launched\n", n_in, n_in > 0 ? in_sizes[0] : -1, out_size, ws_size); grid = -1; return; }
        int dev = 0, cus = 0, per_cu = 0;
        if (hipGetDevice(&dev) != hipSuccess || hipDeviceGetAttribute(&cus, hipDeviceAttributeMultiprocessorCount, dev) != hipSuccess) { grid = -1; return; }
        if (hipFuncSetAttribute((const void*)yoco_fwd, hipFuncAttributeMaxDynamicSharedMemorySize, LDS_BYTES) != hipSuccess) { fprintf(stderr, "kernel_launch: hipFuncSetAttribute failed\n"); grid = -1; return; }
        if (hipOccupancyMaxActiveBlocksPerMultiprocessor(&per_cu, (const void*)yoco_fwd, NWAVES * 64, LDS_BYTES) != hipSuccess || per_cu < 1) { fprintf(stderr, "kernel_launch: occupancy query says %d blocks per CU\n", per_cu); (void)hipGetLastError(); per_cu = 1; }
        grid = cus;
    }
    if (grid < 0) return;
    if (hipMemsetAsync((char*)d_ws + WS_CTL, 0, CTL_ZERO_BYTES, stream) != hipSuccess) { fprintf(stderr, "kernel_launch: hipMemsetAsync failed\n"); return; }
    Args a{};
    for (int i = 0; i < 16; ++i) a.in[i] = (const float*)d_in[i];
    a.out = (float*)d_out; a.ws = (unsigned char*)d_ws;
#if MK_PER_PHASE
    for (int ph = 0; ph < N_PHASES; ++ph) { a.ph_lo = ph; a.ph_hi = ph + 1; hipLaunchKernelGGL(yoco_fwd, dim3(grid), dim3(NWAVES * 64), LDS_BYTES, stream, a); }
#else
    a.ph_lo = 0; a.ph_hi = N_PHASES;
    void* kargs[] = {&a};
    const hipError_t e = hipLaunchCooperativeKernel((const void*)yoco_fwd, dim3(grid), dim3(NWAVES * 64), kargs, LDS_BYTES, stream);
    if (e != hipSuccess) fprintf(stderr, "kernel_launch: cooperative launch failed: %s (grid %d)\n", hipGetErrorString(e), grid);
#endif
}
```

```cpp
#include <hip/hip_runtime.h>
#include <hip/hip_cooperative_groups.h>
#include <cstdio>
#include <cstdint>
namespace cg = cooperative_groups;
namespace pg8 {
#define PG8_LAS __attribute__((address_space(3)))
typedef unsigned short bf16_t;
typedef short bf16x8 __attribute__((ext_vector_type(8)));
typedef float f32x4 __attribute__((ext_vector_type(4)));
typedef unsigned u32x4 __attribute__((ext_vector_type(4)));
constexpr int BM = 256, BK = 64, HALF = 128, HTB = HALF * BK * 2  , STAGE_BYTES = 8 * HTB, NXCD = 8, WGM = 8;

__host__ __device__ __forceinline__ int lds_byte(int r, int c) { const int st = (r >> 4) * 2 + (c >> 5), rr = r & 15, cc = c & 31, ob = rr * 64 + cc * 2; return st * 1024 + (ob ^ (((ob >> 9) & 1) << 5)); }
__host__ __device__ __forceinline__ void stage_rc(int b, int& R, int& C) { const int st = b / 1024, sb = b % 1024, swz = sb ^ (((sb >> 9) & 1) << 5); R = (st >> 1) * 16 + swz / 64; C = (st & 1) * 32 + (swz % 64) / 2; }
__host__ __device__ __forceinline__ int perm32(int rho) { const int n = rho >> 4, i = rho & 15; return 8 * (i >> 2) + 4 * n + (i & 3); }

struct Unit { int pm, pn; };
struct Gemm { const bf16_t* A; const bf16_t* Bt; int M, N, K; };

struct StaticOrder {
    int nM, nN, nwg, G, c;
    __host__ __device__ void init(int M, int N, int G_, int c_) { nM = M / BM; nN = N / BM; nwg = nM * nN; G = G_; c = c_; }
    __host__ __device__ bool next(int i, Unit& u) const {
        const long L = (long)i * G + c; if (L >= nwg) return false;
        int wgid = (int)L; { const int q = nwg / NXCD, r = nwg % NXCD, xcd = wgid % NXCD, off = wgid / NXCD; wgid = (xcd < r ? xcd * (q + 1) : r * (q + 1) + (xcd - r) * q) + off; }
        const int nig = WGM * nN, gid = wgid / nig, fm = gid * WGM, gsz = (nM - fm) < WGM ? (nM - fm) : WGM;
        u.pm = fm + ((wgid % nig) % gsz); u.pn = (wgid % nig) / gsz; return true;
    }
    __device__ __forceinline__ void a_ready(const Unit&) const {}
    __device__ __forceinline__ void done(const Unit&) const {}
};

__device__ __forceinline__ unsigned cvt_pk_bf16(float lo, float hi) { unsigned r; asm volatile("v_cvt_pk_bf16_f32 %0, %1, %2" : "=v"(r) : "v"(lo), "v"(hi)); return r; }
typedef float f32x2 __attribute__((ext_vector_type(2)));
constexpr int EM = 16384, ED = 1024, EFF = 2816, EDA = 2048, ESEQ = 4096;
constexpr float RMS_EPS = 1e-6f;
__device__ __forceinline__ float silu_mul(float g, float u) { return g * u * __builtin_amdgcn_rcpf(1.f + __builtin_amdgcn_exp2f(-1.4426950409f * g)); }
__device__ __forceinline__ float gelu_tanh(float x) { const float t = x * (2.3022081f + 0.10294324f * x * x); return x * __builtin_amdgcn_rcpf(1.f + __builtin_amdgcn_exp2f(-t)); }
__device__ __forceinline__ float rstd_of(const float* ssq, int row) { return __builtin_amdgcn_rsqf(ssq[row] * (1.0f / 1024.0f) + RMS_EPS); }
__device__ __forceinline__ unsigned short bf16_1(float v) { return (unsigned short)(cvt_pk_bf16(v, 0.f) & 0xffffu); }

struct EpiSwiglu {
    static constexpr bool PERM = true, AFTER_DRAIN = false;
    bf16_t* H; const float* ssq; bf16_t* Kb; bf16_t* VT; int nffn;
    __device__ __forceinline__ void operator()(const f32x4 (&acc)[2][2][4][2], const Unit& u, int wr, int wc, int fr, int fq) const {
        const int row0 = u.pm * BM + wr * 64 + fr;
        if (u.pn < nffn) {
            const int col0 = u.pn * 128 + wc * 32 + 8 * fq;
#pragma unroll
            for (int ai = 0; ai < 2; ++ai)
#pragma unroll
                for (int m = 0; m < 4; ++m) { const int row = row0 + ai * HALF + m * 16; const float rs = rstd_of(ssq, row);
                    const f32x4 g0 = acc[ai][0][m][0] * rs, g1 = acc[ai][0][m][1] * rs, u0 = acc[ai][1][m][0] * rs, u1 = acc[ai][1][m][1] * rs;
                    u32x4 w; w.x = cvt_pk_bf16(silu_mul(g0[0], u0[0]), silu_mul(g0[1], u0[1])); w.y = cvt_pk_bf16(silu_mul(g0[2], u0[2]), silu_mul(g0[3], u0[3]));
                    w.z = cvt_pk_bf16(silu_mul(g1[0], u1[0]), silu_mul(g1[1], u1[1])); w.w = cvt_pk_bf16(silu_mul(g1[2], u1[2]), silu_mul(g1[3], u1[3]));
                    *(u32x4*)(H + (size_t)row * EFF + col0) = w; }
        } else {
            const int isv = u.pn - nffn;
#pragma unroll
            for (int ai = 0; ai < 2; ++ai)
#pragma unroll
                for (int m = 0; m < 4; ++m) { const int row = row0 + ai * HALF + m * 16; const float rs = rstd_of(ssq, row);
#pragma unroll
                    for (int bj = 0; bj < 2; ++bj) { const int col = bj * HALF + wc * 32 + 8 * fq; const f32x4 v0 = acc[ai][bj][m][0] * rs, v1 = acc[ai][bj][m][1] * rs;
                        if (isv == 0) { u32x4 w; w.x = cvt_pk_bf16(v0[0], v0[1]); w.y = cvt_pk_bf16(v0[2], v0[3]); w.z = cvt_pk_bf16(v1[0], v1[1]); w.w = cvt_pk_bf16(v1[2], v1[3]);
                            *(u32x4*)(Kb + (size_t)row * 256 + col) = w; }
                        else { const int b = row >> 12, s = row & (ESEQ - 1), kvh = col >> 6, d0 = col & 63;
                            bf16_t* p = VT + ((size_t)((b * 4 + kvh) * 64 + d0)) * ESEQ + s;
#pragma unroll
                            for (int e = 0; e < 4; ++e) { p[(size_t)e * ESEQ] = bf16_1(v0[e]); p[(size_t)(e + 4) * ESEQ] = bf16_1(v1[e]); } } } }
        }
    }
};
__device__ __forceinline__ float bf_lo(unsigned w) { return __uint_as_float(w << 16); }
__device__ __forceinline__ float bf_hi(unsigned w) { return __uint_as_float(w & 0xffff0000u); }
template <bool SRC_F32> struct EpiResid {
    static constexpr bool PERM = true, AFTER_DRAIN = false;
    const float* src32; bf16_t* xb; float* ssq_out; float scale;
    __device__ __forceinline__ void operator()(const f32x4 (&acc)[2][2][4][2], const Unit& u, int wr, int wc, int fr, int fq) const {
        const int row0 = u.pm * BM + wr * 64 + fr, col0 = u.pn * BM + wc * 32 + 8 * fq;
#pragma unroll
        for (int ai = 0; ai < 2; ++ai)
#pragma unroll
            for (int m = 0; m < 4; ++m) { const int row = row0 + ai * HALF + m * 16; float ss = 0.f;
#pragma unroll
                for (int bj = 0; bj < 2; ++bj) { const size_t off = (size_t)row * ED + col0 + bj * HALF;
                    f32x4 a0, a1;
                    if (SRC_F32) { a0 = *(const f32x4*)(src32 + off); a1 = *(const f32x4*)(src32 + off + 4); }
                    else { const u32x4 r = *(const u32x4*)(xb + off); a0 = (f32x4){bf_lo(r.x), bf_hi(r.x), bf_lo(r.y), bf_hi(r.y)}; a1 = (f32x4){bf_lo(r.z), bf_hi(r.z), bf_lo(r.w), bf_hi(r.w)}; }
                    const f32x4 v0 = a0 + acc[ai][bj][m][0] * scale, v1 = a1 + acc[ai][bj][m][1] * scale;
                    ss += (v0[0] * v0[0] + v0[1] * v0[1]) + (v0[2] * v0[2] + v0[3] * v0[3]) + (v1[0] * v1[0] + v1[1] * v1[1]) + (v1[2] * v1[2] + v1[3] * v1[3]);
                    u32x4 w; w.x = cvt_pk_bf16(v0[0], v0[1]); w.y = cvt_pk_bf16(v0[2], v0[3]); w.z = cvt_pk_bf16(v1[0], v1[1]); w.w = cvt_pk_bf16(v1[2], v1[3]);
                    *(u32x4*)(xb + off) = w; }
                ss += __shfl_xor(ss, 16); ss += __shfl_xor(ss, 32);
                if (fq == 0) unsafeAtomicAdd(ssq_out + row, ss);
                if (m & 1) asm volatile("" ::: "memory"); }
    }
};
template <int ACT> struct EpiRowScale {
    static constexpr bool PERM = true, AFTER_DRAIN = false;
    bf16_t* O; int ldc; const float* ssq; float oscale;
    __device__ __forceinline__ void operator()(const f32x4 (&acc)[2][2][4][2], const Unit& u, int wr, int wc, int fr, int fq) const {
        const int row0 = u.pm * BM + wr * 64 + fr, col0 = u.pn * BM + wc * 32 + 8 * fq;
#pragma unroll
        for (int ai = 0; ai < 2; ++ai)
#pragma unroll
            for (int m = 0; m < 4; ++m) { const int row = row0 + ai * HALF + m * 16; const float rs = rstd_of(ssq, row);
#pragma unroll
                for (int bj = 0; bj < 2; ++bj) { f32x4 v0 = acc[ai][bj][m][0] * rs, v1 = acc[ai][bj][m][1] * rs;
                    if (ACT == 1) {
#pragma unroll
                        for (int e = 0; e < 4; ++e) { v0[e] = gelu_tanh(v0[e]); v1[e] = gelu_tanh(v1[e]); } }
                    v0 = v0 * oscale; v1 = v1 * oscale;
                    u32x4 w; w.x = cvt_pk_bf16(v0[0], v0[1]); w.y = cvt_pk_bf16(v0[2], v0[3]); w.z = cvt_pk_bf16(v1[0], v1[1]); w.w = cvt_pk_bf16(v1[2], v1[3]);
                    *(u32x4*)(O + (size_t)row * ldc + col0 + bj * HALF) = w; } }
    }
};
struct EpiGeluVT {
    static constexpr bool PERM = true, AFTER_DRAIN = false;
    bf16_t* VT; const float* ssq; float* vsum; float* vsq;
    __device__ __forceinline__ void operator()(const f32x4 (&acc)[2][2][4][2], const Unit& u, int wr, int wc, int fr, int fq) const {
        const int row0 = u.pm * BM + wr * 64 + fr, col0 = u.pn * BM + wc * 32 + 8 * fq;
#pragma unroll
        for (int bj = 0; bj < 2; ++bj) {
            float rs[8], cs[8], cq[8];
#pragma unroll
            for (int e = 0; e < 8; ++e) { rs[e] = rstd_of(ssq, col0 + bj * HALF + e); cs[e] = 0.f; cq[e] = 0.f; }
#pragma unroll
            for (int ai = 0; ai < 2; ++ai)
#pragma unroll
                for (int m = 0; m < 4; ++m) { const int row = row0 + ai * HALF + m * 16; float v[8];
#pragma unroll
                    for (int e = 0; e < 4; ++e) { v[e] = gelu_tanh(acc[ai][bj][m][0][e] * rs[e]); v[e + 4] = gelu_tanh(acc[ai][bj][m][1][e] * rs[e + 4]); }
#pragma unroll
                    for (int e = 0; e < 8; ++e) { cs[e] += v[e]; cq[e] += v[e] * v[e]; }
                    u32x4 w; w.x = cvt_pk_bf16(v[0], v[1]); w.y = cvt_pk_bf16(v[2], v[3]); w.z = cvt_pk_bf16(v[4], v[5]); w.w = cvt_pk_bf16(v[6], v[7]);
                    *(u32x4*)(VT + (size_t)row * EM + col0 + bj * HALF) = w; }
#pragma unroll
            for (int e = 0; e < 8; ++e) {
#pragma unroll
                for (int o = 1; o < 16; o <<= 1) { cs[e] += __shfl_xor(cs[e], o); cq[e] += __shfl_xor(cq[e], o); } }
            if (fr == 0) {
#pragma unroll
                for (int e = 0; e < 8; ++e) { unsafeAtomicAdd(vsum + col0 + bj * HALF + e, cs[e]); unsafeAtomicAdd(vsq + col0 + bj * HALF + e, cq[e]); } }
        }
    }
};

template <class Epi, class Sched, bool ALIGN_EPI = false, bool SP2 = false>
__device__ __forceinline__ void gemm_phase(PG8_LAS unsigned char* lds, const Gemm g, const Sched& S, const Epi& E) {
    const int tid = threadIdx.x, wid = __builtin_amdgcn_readfirstlane(tid >> 6), lane = tid & 63, wr = wid >> 2, wc = wid & 3, fr = lane & 15, fq = lane >> 4;
    const int K = g.K, nt = K / BK;
    unsigned voffA[2], voffB[2];
#pragma unroll
    for (int i = 0; i < 2; ++i) { int R, C; stage_rc(tid * 16 + i * 8192, R, C); const int Rb = Epi::PERM ? ((R & ~31) + perm32(R & 31)) : R;
        voffA[i] = (unsigned)(R * K + C) * 2u; voffB[i] = (unsigned)(Rb * K + C) * 2u; }
    const size_t kstep = (size_t)(BK * 2);
    const size_t hstep = (size_t)HALF * K * 2;
    const size_t tstep = 2 * hstep;
    const unsigned ldsw = (unsigned)wid * 1024u;
    const int aoff = lds_byte(wr * 64 + fr, fq * 8), boff = lds_byte(wc * 32 + fr, fq * 8);
#define PG8_SA(b, h) (((b) * 2 + (h)) * HTB)
#define PG8_SB(b, h) ((4 + (b) * 2 + (h)) * HTB)
#define PG8_STAGE(bufoff, gbase, voff) do { _Pragma("unroll") for (int _i = 0; _i < 2; ++_i) \
        __builtin_amdgcn_global_load_lds((const unsigned*)((const char*)(gbase) + (voff)[_i]), (PG8_LAS unsigned*)(lds + (bufoff) + ldsw + _i * 8192), 16, 0, 0); } while (0)
#define PG8_LDA(dst, b, h) do { _Pragma("unroll") for (int m = 0; m < 4; ++m) _Pragma("unroll") for (int k = 0; k < 2; ++k) dst[m][k] = *(const PG8_LAS bf16x8*)(lds + PG8_SA(b, h) + aoff + m * 2048 + k * 1024); } while (0)
#define PG8_LDB(dst, b, h) do { _Pragma("unroll") for (int n = 0; n < 2; ++n) _Pragma("unroll") for (int k = 0; k < 2; ++k) dst[n][k] = *(const PG8_LAS bf16x8*)(lds + PG8_SB(b, h) + boff + n * 2048 + k * 1024); } while (0)
#define PG8_MMA(ai, bj, At, Bt) do { __builtin_amdgcn_s_setprio(1); _Pragma("unroll") for (int m = 0; m < 4; ++m) _Pragma("unroll") for (int n = 0; n < 2; ++n) _Pragma("unroll") for (int k = 0; k < 2; ++k) \
        acc[ai][bj][m][n] = __builtin_amdgcn_mfma_f32_16x16x32_bf16(Bt[n][k], At[m][k], acc[ai][bj][m][n], 0, 0, 0); __builtin_amdgcn_s_setprio(0); } while (0)
#define PG8_WAIT_V(n) asm volatile("s_waitcnt vmcnt(" #n ")" ::: "memory")
#define PG8_WAIT_L(n) asm volatile("s_waitcnt lgkmcnt(" #n ")" ::: "memory")
#define PG8_BAR __builtin_amdgcn_s_barrier()
#define PG8_SCHED __builtin_amdgcn_sched_barrier(0)
    Unit cur, nxt; int ui = 0;
    if (!S.next(0, cur)) return;
    f32x4 acc[2][2][4][2];
#pragma unroll
    for (int a = 0; a < 2; ++a)
#pragma unroll
        for (int b = 0; b < 2; ++b)
#pragma unroll
            for (int m = 0; m < 4; ++m)
#pragma unroll
                for (int n = 0; n < 2; ++n) acc[a][b][m][n] = (f32x4){0.f, 0.f, 0.f, 0.f};
    bf16x8 At[4][2], B0[2][2], B1[2][2];
    const char* cA = (const char*)g.A + (size_t)cur.pm * tstep; const char* cB = (const char*)g.Bt + (size_t)cur.pn * tstep;
    S.a_ready(cur);
    if constexpr (SP2) {
        PG8_STAGE(PG8_SB(0, 0), cB, voffB); PG8_STAGE(PG8_SB(0, 1), cB + hstep, voffB); PG8_STAGE(PG8_SA(0, 0), cA, voffA); PG8_STAGE(PG8_SA(0, 1), cA + hstep, voffA);
        if (wr == 1) PG8_BAR;
        PG8_WAIT_V(2); PG8_BAR;
        PG8_STAGE(PG8_SB(1, 0), cB + kstep, voffB); PG8_STAGE(PG8_SA(1, 0), cA + kstep, voffA); PG8_STAGE(PG8_SB(1, 1), cB + hstep + kstep, voffB);
        PG8_WAIT_V(6); PG8_BAR;
    } else {
        PG8_STAGE(PG8_SB(0, 0), cB, voffB); PG8_STAGE(PG8_SA(0, 0), cA, voffA); PG8_STAGE(PG8_SB(0, 1), cB + hstep, voffB); PG8_STAGE(PG8_SA(0, 1), cA + hstep, voffA);
        if (wr == 1) PG8_BAR;
        PG8_WAIT_V(4); PG8_BAR;
        PG8_STAGE(PG8_SB(1, 0), cB + kstep, voffB); PG8_STAGE(PG8_SA(1, 0), cA + kstep, voffA); PG8_STAGE(PG8_SB(1, 1), cB + hstep + kstep, voffB);
        PG8_WAIT_V(6); PG8_BAR;
    }
    for (;;) {
        const bool has_next = S.next(ui + 1, nxt);
        const char* nA = has_next ? (const char*)g.A + (size_t)nxt.pm * tstep : cA; const char* nB = has_next ? (const char*)g.Bt + (size_t)nxt.pn * tstep : cB;
        for (int t = 0; t < nt; t += 2) {
            const bool last = (t == nt - 2);
            const char* a1 = cA + (size_t)(t + 1) * kstep;
            const char* a2 = last ? nA : cA + (size_t)(t + 2) * kstep; const char* b2 = last ? nB : cB + (size_t)(t + 2) * kstep;
            const char* a3 = a2 + kstep; const char* b3 = b2 + kstep;
            if (last && has_next) S.a_ready(nxt);
            if constexpr (SP2) {
            PG8_LDB(B0, 0, 0); PG8_LDB(B1, 0, 1); PG8_SCHED; PG8_LDA(At, 0, 0); PG8_STAGE(PG8_SA(1, 1), a1 + hstep, voffA);
            PG8_WAIT_V(8); PG8_WAIT_L(0); PG8_BAR; PG8_MMA(0, 0, At, B0); PG8_MMA(0, 1, At, B1); PG8_BAR; PG8_SCHED;
            PG8_LDA(At, 0, 1); PG8_STAGE(PG8_SB(0, 0), b2, voffB); PG8_STAGE(PG8_SB(0, 1), b2 + hstep, voffB); PG8_STAGE(PG8_SA(0, 0), a2, voffA);
            PG8_WAIT_V(8); PG8_WAIT_L(0); PG8_BAR; PG8_MMA(1, 0, At, B0); PG8_MMA(1, 1, At, B1); PG8_BAR; PG8_SCHED;
            PG8_LDB(B0, 1, 0); PG8_LDB(B1, 1, 1); PG8_SCHED; PG8_LDA(At, 1, 0); PG8_STAGE(PG8_SA(0, 1), a2 + hstep, voffA);
            PG8_WAIT_V(8); PG8_WAIT_L(0); PG8_BAR; PG8_MMA(0, 0, At, B0); PG8_MMA(0, 1, At, B1); PG8_BAR; PG8_SCHED;
            PG8_LDA(At, 1, 1); PG8_STAGE(PG8_SB(1, 0), b3, voffB); PG8_STAGE(PG8_SB(1, 1), b3 + hstep, voffB); PG8_STAGE(PG8_SA(1, 0), a3, voffA);
            PG8_WAIT_V(8); PG8_WAIT_L(0); PG8_BAR; PG8_MMA(1, 0, At, B0); PG8_MMA(1, 1, At, B1); PG8_BAR; PG8_SCHED;
            } else {
            PG8_LDB(B0, 0, 0); PG8_SCHED; PG8_LDA(At, 0, 0); PG8_STAGE(PG8_SA(1, 1), a1 + hstep, voffA);
            PG8_WAIT_L(8); PG8_BAR; PG8_WAIT_L(0); PG8_MMA(0, 0, At, B0); PG8_BAR; PG8_SCHED;
            PG8_LDB(B1, 0, 1); PG8_STAGE(PG8_SB(0, 0), b2, voffB);
            PG8_BAR; PG8_WAIT_L(0); PG8_MMA(0, 1, At, B1); PG8_BAR;
            PG8_LDA(At, 0, 1); PG8_STAGE(PG8_SA(0, 0), a2, voffA);
            PG8_BAR; PG8_WAIT_L(0); PG8_MMA(1, 0, At, B0); PG8_BAR; PG8_SCHED;
            PG8_STAGE(PG8_SB(0, 1), b2 + hstep, voffB);
            PG8_WAIT_V(6); PG8_BAR; PG8_MMA(1, 1, At, B1); PG8_BAR;
            PG8_LDB(B0, 1, 0); PG8_SCHED; PG8_LDA(At, 1, 0); PG8_STAGE(PG8_SA(0, 1), a2 + hstep, voffA);
            PG8_WAIT_L(8); PG8_BAR; PG8_WAIT_L(0); PG8_MMA(0, 0, At, B0); PG8_BAR; PG8_SCHED;
            PG8_LDB(B1, 1, 1); PG8_STAGE(PG8_SB(1, 0), b3, voffB);
            PG8_BAR; PG8_WAIT_L(0); PG8_MMA(0, 1, At, B1); PG8_BAR;
            PG8_LDA(At, 1, 1); PG8_STAGE(PG8_SA(1, 0), a3, voffA);
            PG8_BAR; PG8_WAIT_L(0); PG8_MMA(1, 0, At, B0); PG8_BAR; PG8_SCHED;
            PG8_STAGE(PG8_SB(1, 1), b3 + hstep, voffB);
            PG8_WAIT_V(6); PG8_BAR; PG8_MMA(1, 1, At, B1); PG8_BAR;
            }
        }
        if constexpr (ALIGN_EPI) { if (wr == 0) PG8_BAR; }
        if constexpr (!Epi::AFTER_DRAIN) { E(acc, cur, wr, wc, fr, fq); S.done(cur); }
        if (!has_next) break;
#pragma unroll
        for (int a = 0; a < 2; ++a)
#pragma unroll
            for (int b = 0; b < 2; ++b)
#pragma unroll
                for (int m = 0; m < 4; ++m)
#pragma unroll
                    for (int n = 0; n < 2; ++n) acc[a][b][m][n] = (f32x4){0.f, 0.f, 0.f, 0.f};
        cur = nxt; cA = nA; cB = nB; ++ui;
        if constexpr (ALIGN_EPI) { if (wr == 1) PG8_BAR; }
    }
    PG8_WAIT_V(0);
    if constexpr (!ALIGN_EPI) { if (wr == 0) PG8_BAR; }
    PG8_BAR;
    if constexpr (Epi::AFTER_DRAIN) { E.fused(acc, cur, wr, wc, fr, fq, lds, wid, lane); S.done(cur); }
#undef PG8_SA
#undef PG8_SB
#undef PG8_STAGE
#undef PG8_LDA
#undef PG8_LDB
#undef PG8_MMA
#undef PG8_WAIT_V
#undef PG8_WAIT_L
#undef PG8_BAR
#undef PG8_SCHED
}
}
constexpr int NWAVES = 8;
constexpr int M = 16384, D = 1024, DFF = 2816, DA = 2048, SEQ = 4096, NBATCH = 4;
constexpr int NIN_FFN = 2 * DFF;
constexpr int NIN_KV = NIN_FFN + 512;
#ifndef MK_PER_PHASE
#define MK_PER_PHASE 0
#endif
constexpr int N_PHASES = 16;
#ifndef PROBE_PHASE
#define PROBE_PHASE -1
#endif

constexpr size_t MiB = 1u << 20;
constexpr size_t WS_CTL = 0, CTL_ZERO_BYTES = 1 * MiB;
constexpr size_t WS_WIN = 2 * MiB;
constexpr size_t WIN_STRIDE = 12 * MiB;
constexpr size_t WS_WOUT = WS_WIN + 4 * WIN_STRIDE;
constexpr size_t WOUT_STRIDE = 6 * MiB;
constexpr size_t WS_AIN = WS_WOUT + 4 * WOUT_STRIDE;
constexpr size_t WS_AOUT = WS_AIN + 8 * MiB;
constexpr size_t WS_WQ = WS_AOUT + 4 * MiB;
constexpr size_t WS_WO = WS_WQ + 2 * MiB;
constexpr size_t WS_XB = WS_WO + 2 * MiB;
constexpr size_t WS_H = WS_XB + 32 * MiB;
constexpr size_t WS_R2 = WS_H + 88 * MiB;
constexpr size_t WS_UV = WS_R2 + 64 * MiB;
constexpr size_t WS_END = WS_UV + 64 * MiB;
constexpr int CW_BAR = 4096;
constexpr int CW_SSQ = 16384;
constexpr int CW_VSUM = CW_SSQ + 7 * M, CW_VSQ = CW_VSUM + M;
static_assert((size_t)(CW_VSQ + M) * 4 <= CTL_ZERO_BYTES, "CTL words inside the memset region");

constexpr int RING_OFF = 0, RING_BYTES = 131072;
constexpr int LDSCTL_OFF = RING_BYTES, MISC_OFF = LDSCTL_OFF + 320;
constexpr int LDS_BYTES = 147456;

#define GAS __attribute__((address_space(1)))
#define LAS __attribute__((address_space(3)))
typedef unsigned short bf16;
typedef unsigned v4u __attribute__((ext_vector_type(4)));
typedef float f32x4 __attribute__((ext_vector_type(4)));
typedef short bf16x8 __attribute__((ext_vector_type(8)));
typedef GAS unsigned gu32;
typedef GAS unsigned long long gu64;
#define RLX_AGENT __ATOMIC_RELAXED, __HIP_MEMORY_SCOPE_AGENT
#define LDS_WAIT() asm volatile("s_waitcnt lgkmcnt(0)" ::: "memory")
#define VM_WAIT() asm volatile("s_waitcnt vmcnt(0)" ::: "memory")
__device__ __forceinline__ unsigned long long rt() { return __builtin_amdgcn_s_memrealtime(); }
__device__ __forceinline__ unsigned f2bf(float f) { unsigned u = __builtin_bit_cast(unsigned, f); return (u + 0x7fffu + ((u >> 16) & 1u)) >> 16; }
__device__ __forceinline__ unsigned pk2(float lo, float hi) { return f2bf(lo) | (f2bf(hi) << 16); }

#define XB_TMO      128
#define XB_XCNT(j)  (256  + 64 * (j))
#define XB_XSUB(j)  (1280 + 64 * (j))
#define XB_XGEN(j)  (2304 + 64 * (j))
#define XB_TOP      3328
#define XB_TOPGEN   3392
#define XCD_BAR_WORDS 3456
#define XB_SPIN_CAP (1u << 18)

__device__ __forceinline__ unsigned xb_ld(unsigned* p)              { return __hip_atomic_load(p, __ATOMIC_RELAXED, __HIP_MEMORY_SCOPE_AGENT); }
__device__ __forceinline__ unsigned xb_add(unsigned* p, unsigned v) { return __hip_atomic_fetch_add(p, v, __ATOMIC_RELAXED, __HIP_MEMORY_SCOPE_AGENT); }
__device__ __forceinline__ unsigned xb_xcc_id() { return (unsigned)__builtin_amdgcn_s_getreg((3 << 11) | 20) & 0xFu; }
#define XB_SPIN(cond, bar) do { unsigned _sp = 0; while (cond) { __builtin_amdgcn_s_sleep(1); \
    if ((++_sp & 255u) == 0u) { if (xb_ld(&(bar)[XB_TMO])) break; if (_sp > XB_SPIN_CAP) { atomicAdd(&(bar)[XB_TMO], 1u); break; } } } } while (0)

struct XcdBarrier {
    unsigned* bar; unsigned x;
    volatile LAS unsigned* st;
};

__device__ __forceinline__ XcdBarrier xcd_barrier_post(unsigned* bar, volatile LAS unsigned* st) {
    XcdBarrier b; b.bar = bar; b.x = xb_xcc_id(); b.st = st;
    if (threadIdx.x == 0) (void)xb_add(&bar[XB_XCNT(b.x)], 1u);
    return b;
}
__device__ __forceinline__ void xcd_barrier_complete(unsigned* bar, unsigned x, unsigned& nloc, unsigned& nx) {
    const unsigned G = gridDim.x * gridDim.y * gridDim.z;
    unsigned sum, cnt, mine, sp = 0u;
    for (;;) {
        sum = 0u; cnt = 0u; mine = 0u;
#pragma unroll
        for (unsigned j = 0; j < 16; ++j) { const unsigned c = xb_ld(&bar[XB_XCNT(j)]); sum += c; cnt += (c > 0u) ? 1u : 0u; mine = (j == x) ? c : mine; }
        if (sum == G) break;
        __builtin_amdgcn_s_sleep(1);
        if ((++sp & 255u) == 0u) { if (xb_ld(&bar[XB_TMO])) break; if (sp > XB_SPIN_CAP) { atomicAdd(&bar[XB_TMO], 1u); break; } }
    }
    nloc = mine > 0u ? mine : 1u; nx = cnt > 0u ? cnt : 1u;
}

__device__ __forceinline__ void xcd_barrier(const XcdBarrier& b) {
    asm volatile("s_waitcnt vmcnt(0)" ::: "memory");
    __syncthreads();
    if (threadIdx.x == 0) {
        unsigned* bar = b.bar;
        __builtin_amdgcn_s_waitcnt(0);
        unsigned nloc = b.st[0], nx = b.st[1];
        if (nloc == 0u) { xcd_barrier_complete(bar, b.x, nloc, nx); b.st[0] = nloc; b.st[1] = nx; }
        const unsigned old = xb_add(&bar[XB_XSUB(b.x)], 1u);
        const unsigned gen = old / nloc;
        if (old + 1u == (gen + 1u) * nloc) {
            __builtin_amdgcn_fence(__ATOMIC_RELEASE, "agent");
            asm volatile("s_waitcnt vmcnt(0)" ::: "memory");
            const unsigned og = xb_add(&bar[XB_TOP], 1u);
            const unsigned tg = og / nx;
            if (og + 1u == (tg + 1u) * nx) xb_add(&bar[XB_TOPGEN], 1u);
            else XB_SPIN(xb_ld(&bar[XB_TOPGEN]) == tg, bar);
            __builtin_amdgcn_fence(__ATOMIC_ACQUIRE, "agent");
            xb_add(&bar[XB_XGEN(b.x)], 1u);
            asm volatile("s_waitcnt vmcnt(0)" ::: "memory");
        } else {
            XB_SPIN(xb_ld(&bar[XB_XGEN(b.x)]) == gen, bar);
            __builtin_amdgcn_fence(__ATOMIC_ACQUIRE, "agent");
            asm volatile("s_waitcnt vmcnt(0)" ::: "memory");
        }
    }
    __syncthreads();
}
typedef float f32x16 __attribute__((ext_vector_type(16)));
typedef short s16x4 __attribute__((ext_vector_type(4)));
typedef unsigned v2u __attribute__((ext_vector_type(2)));
typedef float f32x2_t __attribute__((ext_vector_type(2))); typedef __bf16 bf16x2_t __attribute__((ext_vector_type(2)));
__device__ __forceinline__ unsigned cvtpk(float lo, float hi) { f32x2_t v = {lo, hi}; bf16x2_t b = __builtin_convertvector(v, bf16x2_t); return __builtin_bit_cast(unsigned, b); }
__device__ __forceinline__ float bflo(unsigned w) { return __uint_as_float(w << 16); }
__device__ __forceinline__ float bfhi(unsigned w) { return __uint_as_float(w & 0xffff0000u); }

struct Frame {
    LAS unsigned char* lds;
    volatile LAS unsigned* MISC;
    gu32* ctl;
    int tid, lane, wave;
    int vcu, G;
};
__device__ __forceinline__ float wave_sum(float v) {
#pragma unroll
    for (int o = 1; o < 64; o <<= 1) v += __shfl_xor(v, o);
    return v;
}
__device__ __forceinline__ void p0_item(const float* W, int ldn, int K, int nblk, bf16* WT, const float* gk, int mode, LAS float* scr, int item, int lane) {
    const int kb = item / nblk, nb = item % nblk, k0 = 64 * kb, n0 = 32 * nb;
    const int rowb = (mode == 0) ? n0 : (256 * (n0 >> 7) + (n0 & 127) + (mode == 2 ? 128 : 0));
    const int kr = lane >> 3, n4 = (lane & 7) * 4;
    f32x4 w[8];
#pragma unroll
    for (int i = 0; i < 8; ++i) w[i] = *(const GAS f32x4*)(W + (size_t)(k0 + i * 8 + kr) * ldn + n0 + n4);
    if (gk) {
#pragma unroll
        for (int i = 0; i < 8; ++i) w[i] = w[i] * gk[k0 + i * 8 + kr]; }
#pragma unroll
    for (int i = 0; i < 8; ++i) { LAS float* d = scr + (i * 8 + kr) * 33 + n4; d[0] = w[i].x; d[1] = w[i].y; d[2] = w[i].z; d[3] = w[i].w; }
    LDS_WAIT(); asm volatile("" ::: "memory");
    const int c = lane & 7;
#pragma unroll
    for (int j = 0; j < 4; ++j) { const int n = (lane >> 3) + 8 * j; const LAS float* s = scr + (8 * c) * 33 + n;
        v4u o; o.x = pk2(s[0 * 33], s[1 * 33]); o.y = pk2(s[2 * 33], s[3 * 33]); o.z = pk2(s[4 * 33], s[5 * 33]); o.w = pk2(s[6 * 33], s[7 * 33]);
        *(GAS v4u*)(WT + (size_t)(rowb + n) * K + k0 + 8 * c) = o; }
    LDS_WAIT(); asm volatile("" ::: "memory");
}
struct Ptrs {
    const float *x, *ffn_norm, *ffn_w_in, *ffn_w_out, *mix_norm, *a_w_in, *a_ln_g, *a_ln_b, *a_w_s, *a_b_s, *a_w_out, *kv_norm, *w_kv, *b_w_q, *b_w_o, *final_norm;
    float* X;
    bf16 *WIN, *WOUT, *AIN, *AOUT, *WQ, *WO, *XB, *H, *U, *UV, *O, *VTs, *Q, *Kb, *VTa;
    float *ssq, *vsum, *vsq;
};
__device__ __forceinline__ void p0_prologue(Frame& F, const Ptrs& P) {
    LAS float* scr = (LAS float*)(F.lds + RING_OFF + F.wave * 16384);
    const int gw = F.vcu * NWAVES + F.wave, NGW = F.G * NWAVES;
    constexpr int I_IN = 16 * (DFF / 32);
    constexpr int I_KV = 16 * (512 / 32);
    constexpr int I_OUT = (DFF / 64) * (D / 32);
    constexpr int I_AIN = 16 * (2 * DA / 32);
    constexpr int I_AOUT = (DA / 64) * (D / 32);
    constexpr int I_Q = 16 * 32;
    constexpr int NITEMS = 8 * I_IN + I_KV + 4 * I_OUT + I_AIN + I_AOUT + 2 * I_Q;
    for (int it = gw; it < NITEMS; it += NGW) {
        int r = it;
        if (r < 8 * I_IN) { const int mat = r / (2 * I_IN), rr = r % (2 * I_IN), up = rr / I_IN, item = rr % I_IN;
            p0_item(P.ffn_w_in + (size_t)mat * D * NIN_FFN + up * DFF, NIN_FFN, D, DFF / 32, (bf16*)((char*)P.WIN + mat * WIN_STRIDE), P.ffn_norm + mat * D, 1 + up, scr, item, F.lane); continue; }
        r -= 8 * I_IN;
        if (r < I_KV) { p0_item(P.w_kv, 512, D, 16, (bf16*)((char*)P.WIN + 2 * WIN_STRIDE) + (size_t)NIN_FFN * D, P.kv_norm, 0, scr, r, F.lane); continue; }
        r -= I_KV;
        if (r < 4 * I_OUT) { const int mat = r / I_OUT, item = r % I_OUT;
            p0_item(P.ffn_w_out + (size_t)mat * DFF * D, D, DFF, D / 32, (bf16*)((char*)P.WOUT + mat * WOUT_STRIDE), nullptr, 0, scr, item, F.lane); continue; }
        r -= 4 * I_OUT;
        if (r < I_AIN) { p0_item(P.a_w_in, 2 * DA, D, 2 * DA / 32, P.AIN, P.mix_norm, 0, scr, r, F.lane); continue; }
        r -= I_AIN;
        if (r < I_AOUT) { p0_item(P.a_w_out, D, DA, D / 32, P.AOUT, nullptr, 0, scr, r, F.lane); continue; }
        r -= I_AOUT;
        if (r < I_Q) { p0_item(P.b_w_q, D, D, D / 32, P.WQ, P.mix_norm + D, 0, scr, r, F.lane); continue; }
        r -= I_Q;
        p0_item(P.b_w_o, D, D, D / 32, P.WO, nullptr, 0, scr, r, F.lane);
    }
    for (int m = gw; m < M; m += NGW) {
        const GAS f32x4* xr = (const GAS f32x4*)(P.x + (size_t)m * D) + F.lane;
        f32x4 v[4]; float s = 0.f;
#pragma unroll
        for (int j = 0; j < 4; ++j) { v[j] = xr[64 * j]; s += (v[j].x * v[j].x + v[j].y * v[j].y) + (v[j].z * v[j].z + v[j].w * v[j].w); }
        s = wave_sum(s);
        GAS unsigned long long* o8 = (GAS unsigned long long*)(P.XB + (size_t)m * D) + F.lane;
#pragma unroll
        for (int j = 0; j < 4; ++j) o8[64 * j] = (unsigned long long)pk2(v[j].x, v[j].y) | ((unsigned long long)pk2(v[j].z, v[j].w) << 32);
        if (F.lane == 0) P.ssq[m] = s;
    }
}
__device__ __forceinline__ void final_norm_phase(Frame& F, const Ptrs& P) {
    const int gw = F.vcu * NWAVES + F.wave, NGW = F.G * NWAVES;
    f32x4 g0[2], g1[2];
#pragma unroll
    for (int j = 0; j < 2; ++j) { g0[j] = ((const GAS f32x4*)P.final_norm)[2 * F.lane + 128 * j]; g1[j] = ((const GAS f32x4*)P.final_norm)[2 * F.lane + 128 * j + 1]; }
    for (int m = gw; m < M; m += NGW) {
        const float rs = __builtin_amdgcn_rsqf(P.ssq[6 * M + m] * (1.0f / 1024.0f) + 1e-6f);
#pragma unroll
        for (int j = 0; j < 2; ++j) { const v4u r = ((const GAS v4u*)(P.XB + (size_t)m * D))[F.lane + 64 * j];
            GAS f32x4* o = (GAS f32x4*)(P.X + (size_t)m * D) + 2 * F.lane + 128 * j;
            o[0] = (f32x4){bflo(r.x), bfhi(r.x), bflo(r.y), bfhi(r.y)} * rs * g0[j]; o[1] = (f32x4){bflo(r.z), bfhi(r.z), bflo(r.w), bfhi(r.w)} * rs * g1[j]; }
    }
}

constexpr int SG_WM = 0, SG_LD = 272, SG_BT = 128 * SG_LD  , SG_CLD = 528, SG_STAT = SG_BT + 256 * SG_LD  ;
static_assert(128 * SG_CLD <= 256 * SG_LD && SG_STAT + 1024 <= RING_BYTES, "sgu LDS map");
__device__ __forceinline__ void sgu_phase(Frame& F, const Ptrs& P) {
    LAS unsigned char* lds = F.lds + RING_OFF;
    const int tid = F.tid, lane = F.lane, wid = F.wave, fr = lane & 15, fq = lane >> 4, wt = wid >> 2, wc = wid & 3;
    int gload = -1;
    for (int un = F.vcu; un < 1024; un += F.G) {
        const int g = un & 7, chunk = un >> 3, tok0 = chunk * 128;
        __syncthreads();
        if (g != gload) {
            const float* ws = P.a_w_s + (size_t)g * 128 * 128;
#pragma unroll
            for (int i = 0; i < 4; ++i) { const int idx = i * 512 + tid, t = idx >> 4, s8 = (idx & 15) * 8;
                const f32x4 a = *(const GAS f32x4*)(ws + t * 128 + s8), b = *(const GAS f32x4*)(ws + t * 128 + s8 + 4);
                float v[8] = {a.x, a.y, a.z, a.w, b.x, b.y, b.z, b.w};
#pragma unroll
                for (int e = 0; e < 8; ++e) v[e] = (s8 + e <= t) ? v[e] : 0.f;
                v4u o; o.x = cvtpk(v[0], v[1]); o.y = cvtpk(v[2], v[3]); o.z = cvtpk(v[4], v[5]); o.w = cvtpk(v[6], v[7]);
                *(LAS v4u*)(lds + SG_WM + t * SG_LD + s8 * 2) = o; }
            gload = g;
        }
        if (tid < 128) { const float sm = P.vsum[tok0 + tid], sq = P.vsq[tok0 + tid]; const float mean = sm * (1.0f / 2048.0f);
            const float var = fmaxf(sq * (1.0f / 2048.0f) - mean * mean, 0.f);
            ((LAS float*)(lds + SG_STAT))[tid] = mean; ((LAS float*)(lds + SG_STAT))[128 + tid] = __builtin_amdgcn_rsqf(var + 1e-5f); }
        __syncthreads();
        {
            const int s8 = (tid & 15) * 8; float mu[8], rsd[8];
#pragma unroll
            for (int e = 0; e < 8; ++e) { mu[e] = ((LAS float*)(lds + SG_STAT))[s8 + e]; rsd[e] = ((LAS float*)(lds + SG_STAT))[128 + s8 + e]; }
#pragma unroll
            for (int i = 0; i < 8; ++i) { const int c = i * 32 + (tid >> 4), cgl = g * 256 + c;
                const v4u w = *(const GAS v4u*)(P.VTs + (size_t)cgl * M + tok0 + s8); const float lg = P.a_ln_g[cgl], lb = P.a_ln_b[cgl];
                float v[8] = {bflo(w.x), bfhi(w.x), bflo(w.y), bfhi(w.y), bflo(w.z), bfhi(w.z), bflo(w.w), bfhi(w.w)};
#pragma unroll
                for (int e = 0; e < 8; ++e) v[e] = (v[e] - mu[e]) * rsd[e] * lg + lb;
                v4u o; o.x = cvtpk(v[0], v[1]); o.y = cvtpk(v[2], v[3]); o.z = cvtpk(v[4], v[5]); o.w = cvtpk(v[6], v[7]);
                *(LAS v4u*)(lds + SG_BT + c * SG_LD + s8 * 2) = o; }
        }
        __syncthreads();
        f32x4 acc[4][4];
#pragma unroll
        for (int a = 0; a < 4; ++a)
#pragma unroll
            for (int b = 0; b < 4; ++b) acc[a][b] = (f32x4){0.f, 0.f, 0.f, 0.f};
#pragma unroll
        for (int ks = 0; ks < 4; ++ks) { bf16x8 af[4], bfr[4];
#pragma unroll
            for (int i = 0; i < 4; ++i) { af[i] = *(const LAS bf16x8*)(lds + SG_WM + (wt * 64 + i * 16 + fr) * SG_LD + (ks * 32 + fq * 8) * 2);
                                          bfr[i] = *(const LAS bf16x8*)(lds + SG_BT + (wc * 64 + i * 16 + fr) * SG_LD + (ks * 32 + fq * 8) * 2); }
#pragma unroll
            for (int mt = 0; mt < 4; ++mt)
#pragma unroll
                for (int nt = 0; nt < 4; ++nt) acc[mt][nt] = __builtin_amdgcn_mfma_f32_16x16x32_bf16(bfr[nt], af[mt], acc[mt][nt], 0, 0, 0); }
        __syncthreads();
#pragma unroll
        for (int mt = 0; mt < 4; ++mt) { const int t = wt * 64 + mt * 16 + fr; const float bs = P.a_b_s[g * 128 + t];
#pragma unroll
            for (int nt = 0; nt < 4; ++nt) { const int c = wc * 64 + nt * 16 + 4 * fq; const f32x4 v = acc[mt][nt] + bs;
                v2u o; o.x = cvtpk(v[0], v[1]); o.y = cvtpk(v[2], v[3]); *(LAS v2u*)(lds + SG_BT + t * SG_CLD + c * 2) = o; } }
        __syncthreads();
#pragma unroll
        for (int i = 0; i < 8; ++i) { const int idx = i * 512 + tid, t = idx >> 5, c8 = (idx & 31) * 8;
            const v4u cw = *(const LAS v4u*)(lds + SG_BT + t * SG_CLD + c8 * 2);
            const size_t uoff = (size_t)(tok0 + t) * DA + g * 256 + c8; const v4u uw = *(const GAS v4u*)(P.U + uoff);
            v4u o; o.x = cvtpk(bflo(cw.x) * bflo(uw.x), bfhi(cw.x) * bfhi(uw.x)); o.y = cvtpk(bflo(cw.y) * bflo(uw.y), bfhi(cw.y) * bfhi(uw.y));
            o.z = cvtpk(bflo(cw.z) * bflo(uw.z), bfhi(cw.z) * bfhi(uw.z)); o.w = cvtpk(bflo(cw.w) * bflo(uw.w), bfhi(cw.w) * bfhi(uw.w));
            *(GAS v4u*)(P.UV + uoff) = o; }
    }
    __syncthreads();
}

constexpr int AT_K = 0, AT_KLD = 144, AT_V = 64 * AT_KLD  , AT_VLD = 136, AT_FLAG = AT_V + 64 * AT_VLD  ;
constexpr float SB_DONE = -150.0f;
__device__ __forceinline__ int crow(int r, int hi) { return (r & 3) + 8 * (r >> 2) + 4 * hi; }
template <bool MASKED> __device__ __forceinline__ void sb_block(f32x16& p, float& carry, int hi, int qloc, unsigned (&pk)[8]) {
    float l[16];
#pragma unroll
    for (int i = 0; i < 16; ++i) { const float z = p[i]; const float sp = fmaxf(z, 0.f) + __builtin_amdgcn_logf(1.f + __builtin_amdgcn_exp2f(-fabsf(z)));
        l[i] = -sp; if (MASKED) { if (!(crow(i, hi) < qloc)) l[i] = 0.f; } }
    float gs[4], pg[4];
#pragma unroll
    for (int g = 0; g < 4; ++g) gs[g] = (l[4 * g] + l[4 * g + 1]) + (l[4 * g + 2] + l[4 * g + 3]);
#pragma unroll
    for (int g = 0; g < 4; ++g) pg[g] = __shfl_xor(gs[g], 32);
    const float t0 = gs[0] + pg[0], t1 = gs[1] + pg[1], t2 = gs[2] + pg[2], t3 = gs[3] + pg[3];
    float above[4]; above[3] = 0.f; above[2] = t3; above[1] = t3 + t2; above[0] = t3 + t2 + t1;
    const float total = above[0] + t0;
#pragma unroll
    for (int g = 0; g < 4; ++g) { float c = carry + above[g] + (hi == 0 ? pg[g] : 0.f);
#pragma unroll
        for (int e = 3; e >= 0; --e) { const int i = 4 * g + e; c += l[i]; float a = __builtin_amdgcn_exp2f(p[i] + c); if (MASKED) { if (!(crow(i, hi) < qloc)) a = 0.f; } p[i] = a; } }
    carry += total;
#pragma unroll
    for (int j = 0; j < 8; ++j) pk[j] = cvtpk(p[2 * j], p[2 * j + 1]);
}
__device__ __forceinline__ void attn_phase(Frame& F, const Ptrs& P) {
    LAS unsigned char* lds = F.lds + RING_OFF;
    volatile LAS unsigned* flag = (volatile LAS unsigned*)(lds + AT_FLAG);
    const int tid = F.tid, lane = F.lane, wid = F.wave, r32 = lane & 31, hi = lane >> 5, half = wid & 1;
    for (int un = F.vcu; un < 1024; un += F.G) {
        const int bk = un & 15, qb = un >> 4, b = bk >> 2, kvh = bk & 3, hq = kvh * 4 + (wid >> 1);
        const size_t qrow = (size_t)b * SEQ + qb * 64 + half * 32 + r32;
        bf16x8 qr[4];
#pragma unroll
        for (int d0 = 0; d0 < 4; ++d0) qr[d0] = *(const GAS bf16x8*)(P.Q + qrow * D + hq * 64 + d0 * 16 + hi * 8);
        f32x16 o0, o1;
#pragma unroll
        for (int i = 0; i < 16; ++i) { o0[i] = 0.f; o1[i] = 0.f; }
        float carry = 0.f; bool active = true; int it = 0;
        for (int kt = qb; kt >= 0; --kt, ++it) {
            __syncthreads();
            if (it > 0) { if (flag[(it - 1) & 1] == 0u) break; }
            if (tid == 0) flag[it & 1] = 0u;
            {
                const int r = tid >> 3, c8 = (tid & 7) * 8;
                const v4u kw = *(const GAS v4u*)(P.Kb + ((size_t)b * SEQ + kt * 64 + r) * 256 + kvh * 64 + c8);
                const v4u vw = *(const GAS v4u*)(P.VTa + ((size_t)(bk * 64 + r)) * SEQ + kt * 64 + c8);
                *(LAS v4u*)(lds + AT_K + r * AT_KLD + c8 * 2) = kw;
                *(LAS v2u*)(lds + AT_V + r * AT_VLD + c8 * 2) = (v2u){vw.x, vw.y}; *(LAS v2u*)(lds + AT_V + r * AT_VLD + c8 * 2 + 8) = (v2u){vw.z, vw.w};
            }
            __syncthreads();
            if (active) {
                const bool diag = (kt == qb);
#pragma unroll
                for (int blk = 1; blk >= 0; --blk) {
                    if (diag && blk > half) continue;
                    f32x16 p;
#pragma unroll
                    for (int i = 0; i < 16; ++i) p[i] = 0.f;
#pragma unroll
                    for (int d0 = 0; d0 < 4; ++d0) { const bf16x8 kf = *(const LAS bf16x8*)(lds + AT_K + (blk * 32 + r32) * AT_KLD + (d0 * 16 + hi * 8) * 2);
                        p = __builtin_amdgcn_mfma_f32_32x32x16_bf16(kf, qr[d0], p, 0, 0, 0); }
                    unsigned pk[8];
                    if (diag && blk == half) sb_block<true>(p, carry, hi, r32, pk); else sb_block<false>(p, carry, hi, r32, pk);
#pragma unroll
                    for (int s = 0; s < 2; ++s) { const bf16x8 pf = __builtin_bit_cast(bf16x8, (v4u){pk[4 * s], pk[4 * s + 1], pk[4 * s + 2], pk[4 * s + 3]});
#pragma unroll
                        for (int db = 0; db < 2; ++db) { const LAS unsigned char* vp = lds + AT_V + (db * 32 + r32) * AT_VLD + (blk * 32 + 16 * s + 4 * hi) * 2;
                            const v2u lo = *(const LAS v2u*)vp, hh = *(const LAS v2u*)(vp + 16);
                            const bf16x8 vf = __builtin_bit_cast(bf16x8, (v4u){lo.x, lo.y, hh.x, hh.y});
                            if (db == 0) o0 = __builtin_amdgcn_mfma_f32_32x32x16_bf16(vf, pf, o0, 0, 0, 0); else o1 = __builtin_amdgcn_mfma_f32_32x32x16_bf16(vf, pf, o1, 0, 0, 0); } }
                }
                if (__any(carry > SB_DONE)) { if (lane == 0) flag[it & 1] = 1u; } else active = false;
            }
        }
        bf16* op = P.O + qrow * D + hq * 64;
#pragma unroll
        for (int g = 0; g < 4; ++g) { v2u w0, w1; w0.x = cvtpk(o0[4 * g], o0[4 * g + 1]); w0.y = cvtpk(o0[4 * g + 2], o0[4 * g + 3]); w1.x = cvtpk(o1[4 * g], o1[4 * g + 1]); w1.y = cvtpk(o1[4 * g + 2], o1[4 * g + 3]);
            *(GAS v2u*)(op + 8 * g + 4 * hi) = w0; *(GAS v2u*)(op + 32 + 8 * g + 4 * hi) = w1; }
    }
    __syncthreads();
}

struct Args { const float* in[16]; float* out; unsigned char* ws; int ph_lo, ph_hi; };
__global__ void __launch_bounds__(NWAVES * 64, 2) yoco_fwd(Args args) {
    extern __shared__ __attribute__((aligned(16))) unsigned char lds[];
    Frame F;
    F.lds = (LAS unsigned char*)lds;
    F.MISC = (volatile LAS unsigned*)(F.lds + MISC_OFF);
    F.tid = threadIdx.x; F.lane = F.tid & 63; F.wave = __builtin_amdgcn_readfirstlane(F.tid >> 6);
    F.G = gridDim.x; { const int bx = blockIdx.x; F.vcu = (F.G % 8 == 0) ? (bx % 8) * (F.G / 8) + bx / 8 : bx; }
    unsigned char* ws = args.ws;
    F.ctl = (gu32*)(ws + WS_CTL);
    Ptrs P;
    P.x = args.in[0]; P.ffn_norm = args.in[1]; P.ffn_w_in = args.in[2]; P.ffn_w_out = args.in[3]; P.mix_norm = args.in[4]; P.a_w_in = args.in[5]; P.a_ln_g = args.in[6]; P.a_ln_b = args.in[7];
    P.a_w_s = args.in[8]; P.a_b_s = args.in[9]; P.a_w_out = args.in[10]; P.kv_norm = args.in[11]; P.w_kv = args.in[12]; P.b_w_q = args.in[13]; P.b_w_o = args.in[14]; P.final_norm = args.in[15];
    P.X = args.out;
    P.WIN = (bf16*)(ws + WS_WIN); P.WOUT = (bf16*)(ws + WS_WOUT); P.AIN = (bf16*)(ws + WS_AIN); P.AOUT = (bf16*)(ws + WS_AOUT); P.WQ = (bf16*)(ws + WS_WQ); P.WO = (bf16*)(ws + WS_WO);
    P.XB = (bf16*)(ws + WS_XB); P.H = (bf16*)(ws + WS_H); P.U = (bf16*)(ws + WS_H); P.UV = (bf16*)(ws + WS_UV); P.O = (bf16*)(ws + WS_H); P.VTs = (bf16*)(ws + WS_R2);
    P.Q = (bf16*)(ws + WS_R2); P.Kb = (bf16*)(ws + WS_R2 + 32 * MiB); P.VTa = (bf16*)(ws + WS_R2 + 40 * MiB);
    P.ssq = (float*)(ws + WS_CTL) + CW_SSQ; P.vsum = (float*)(ws + WS_CTL) + CW_VSUM; P.vsq = (float*)(ws + WS_CTL) + CW_VSQ;
    for (int u = F.tid; u < (LDS_BYTES - LDSCTL_OFF) / 4; u += NWAVES * 64) ((LAS unsigned*)(F.lds + LDSCTL_OFF))[u] = 0u;
    __syncthreads();
    XcdBarrier bar; bar.bar = (unsigned*)(F.ctl + CW_BAR); bar.x = 0; bar.st = nullptr;
#if !MK_PER_PHASE
    bar = xcd_barrier_post((unsigned*)(F.ctl + CW_BAR), F.MISC + 8);
#endif
    const int lo = args.ph_lo, hi = args.ph_hi;
#define IN(k) (lo <= (k) && (k) < hi)
#if MK_PER_PHASE
#define SEAM(k) do { } while (0)
#define SEAM_CG(k) do { } while (0)
#else
#define SEAM(k) do { if (IN(k) && IN((k) + 1)) xcd_barrier(bar); } while (0)
#define SEAM_CG(k) do { if (IN(k) && IN((k) + 1)) { asm volatile("s_waitcnt vmcnt(0)" ::: "memory"); __threadfence(); cg::this_grid().sync(); } } while (0)
#endif
    using pg8::Gemm; using pg8::StaticOrder;
    LAS unsigned char* ring = F.lds + RING_OFF;
    const int bid = (int)blockIdx.x;
#define WINp(mat) ((const pg8::bf16_t*)((const char*)P.WIN + (size_t)(mat) * WIN_STRIDE))
#define WOUTp(mat) ((const pg8::bf16_t*)((const char*)P.WOUT + (size_t)(mat) * WOUT_STRIDE))
#define FFN_IN(mat, nn, ssqi) do { Gemm g{(const pg8::bf16_t*)P.XB, WINp(mat), M, (nn), D}; StaticOrder S; S.init(M, (nn), F.G, bid); \
        pg8::EpiSwiglu E{(pg8::bf16_t*)P.H, P.ssq + (ssqi) * M, (pg8::bf16_t*)P.Kb, (pg8::bf16_t*)P.VTa, NIN_FFN / 256}; \
        pg8::gemm_phase<pg8::EpiSwiglu, StaticOrder, true, true>(ring, g, S, E); } while (0)
#define FFN_OUT(mat, F32, ssqo) do { Gemm g{(const pg8::bf16_t*)P.H, WOUTp(mat), M, D, DFF}; StaticOrder S; S.init(M, D, F.G, bid); \
        pg8::EpiResid<F32> E{P.x, (pg8::bf16_t*)P.XB, P.ssq + (ssqo) * M, 0.5f}; \
        pg8::gemm_phase<pg8::EpiResid<F32>, StaticOrder, true, true>(ring, g, S, E); } while (0)

    if (IN(0)) { p0_prologue(F, P); if (PROBE_PHASE == 0) p0_prologue(F, P); } SEAM_CG(0);
    if (IN(1)) { FFN_IN(0, NIN_FFN, 0); if (PROBE_PHASE == 1) FFN_IN(0, NIN_FFN, 0); } SEAM(1);
    if (IN(2)) { FFN_OUT(0, true, 1);
        if (PROBE_PHASE == 2) { Gemm g{(const pg8::bf16_t*)P.H, WOUTp(0), M, D, DFF}; StaticOrder S; S.init(M, D, F.G, bid);
            pg8::EpiResid<true> E{P.x, (pg8::bf16_t*)(ws + WS_R2), (float*)(ws + WS_CTL) + 196608, 0.5f};
            pg8::gemm_phase<pg8::EpiResid<true>, StaticOrder, true, true>(ring, g, S, E); } } SEAM(2);
    if (IN(3)) {
        { Gemm g{(const pg8::bf16_t*)P.XB, (const pg8::bf16_t*)P.AIN, M, DA, D}; StaticOrder S; S.init(M, DA, F.G, bid);
          pg8::EpiRowScale<1> E{(pg8::bf16_t*)P.U, DA, P.ssq + 1 * M, 1.0f};
          pg8::gemm_phase<pg8::EpiRowScale<1>, StaticOrder, true, true>(ring, g, S, E); }
        { Gemm g{(const pg8::bf16_t*)P.AIN + (size_t)DA * D, (const pg8::bf16_t*)P.XB, DA, M, D}; StaticOrder S; S.init(DA, M, F.G, bid);
          pg8::EpiGeluVT E{(pg8::bf16_t*)P.VTs, P.ssq + 1 * M, P.vsum, P.vsq};
          pg8::gemm_phase<pg8::EpiGeluVT, StaticOrder, true, true>(ring, g, S, E); }
    } SEAM(3);
    if (IN(4)) { sgu_phase(F, P); if (PROBE_PHASE == 4) sgu_phase(F, P); } SEAM(4);
    if (IN(5)) { Gemm g{(const pg8::bf16_t*)P.UV, (const pg8::bf16_t*)P.AOUT, M, D, DA}; StaticOrder S; S.init(M, D, F.G, bid);
        pg8::EpiResid<false> E{P.x, (pg8::bf16_t*)P.XB, P.ssq + 2 * M, 1.0f};
        pg8::gemm_phase<pg8::EpiResid<false>, StaticOrder, true, true>(ring, g, S, E); } SEAM(5);
    if (IN(6)) { FFN_IN(1, NIN_FFN, 2); } SEAM(6);
    if (IN(7)) { FFN_OUT(1, false, 3); } SEAM(7);
    if (IN(8)) { FFN_IN(2, NIN_KV, 3); } SEAM(8);
    if (IN(9)) { FFN_OUT(2, false, 4); } SEAM(9);
    if (IN(10)) { Gemm g{(const pg8::bf16_t*)P.XB, (const pg8::bf16_t*)P.WQ, M, D, D}; StaticOrder S; S.init(M, D, F.G, bid);
        pg8::EpiRowScale<0> E{(pg8::bf16_t*)P.Q, D, P.ssq + 4 * M, 0.125f * 1.4426950409f};
        pg8::gemm_phase<pg8::EpiRowScale<0>, StaticOrder, true, true>(ring, g, S, E); } SEAM(10);
    if (IN(11)) { attn_phase(F, P); if (PROBE_PHASE == 11) attn_phase(F, P); } SEAM(11);
    if (IN(12)) { Gemm g{(const pg8::bf16_t*)P.O, (const pg8::bf16_t*)P.WO, M, D, D}; StaticOrder S; S.init(M, D, F.G, bid);
        pg8::EpiResid<false> E{P.x, (pg8::bf16_t*)P.XB, P.ssq + 5 * M, 1.0f};
        pg8::gemm_phase<pg8::EpiResid<false>, StaticOrder, true, true>(ring, g, S, E); } SEAM(12);
    if (IN(13)) { FFN_IN(3, NIN_FFN, 5); } SEAM(13);
    if (IN(14)) { FFN_OUT(3, false, 6); } SEAM(14);
    if (IN(15)) { final_norm_phase(F, P); }
#undef IN
}

extern "C" void kernel_launch(void* const* d_in, const int* in_sizes, int n_in, void* d_out, int out_size, void* d_ws, size_t ws_size, hipStream_t stream) {
    static int grid = 0;
    if (grid == 0) {
        if (n_in != 16 || in_sizes[0] != M * D || out_size != M * D || ws_size < WS_END) { fprintf(stderr, "kernel_launch: unexpected shapes / workspace (n_in %d, in0 %d, out %d, ws %zu); nothing launched\n", n_in, n_in > 0 ? in_sizes[0] : -1, out_size, ws_size); grid = -1; return; }
        int dev = 0, cus = 0, per_cu = 0;
        if (hipGetDevice(&dev) != hipSuccess || hipDeviceGetAttribute(&cus, hipDeviceAttributeMultiprocessorCount, dev) != hipSuccess) { grid = -1; return; }
        if (hipFuncSetAttribute((const void*)yoco_fwd, hipFuncAttributeMaxDynamicSharedMemorySize, LDS_BYTES) != hipSuccess) { fprintf(stderr, "kernel_launch: hipFuncSetAttribute failed\n"); grid = -1; return; }
        if (hipOccupancyMaxActiveBlocksPerMultiprocessor(&per_cu, (const void*)yoco_fwd, NWAVES * 64, LDS_BYTES) != hipSuccess || per_cu < 1) { fprintf(stderr, "kernel_launch: occupancy query says %d blocks per CU\n", per_cu); (void)hipGetLastError(); per_cu = 1; }
        grid = cus;
    }
    if (grid < 0) return;
    if (hipMemsetAsync((char*)d_ws + WS_CTL, 0, CTL_ZERO_BYTES, stream) != hipSuccess) { fprintf(stderr, "kernel_launch: hipMemsetAsync failed\n"); return; }
    Args a{};
    for (int i = 0; i < 16; ++i) a.in[i] = (const float*)d_in[i];
    a.out = (float*)d_out; a.ws = (unsigned char*)d_ws;
#if MK_PER_PHASE
    for (int ph = 0; ph < N_PHASES; ++ph) { a.ph_lo = ph; a.ph_hi = ph + 1; hipLaunchKernelGGL(yoco_fwd, dim3(grid), dim3(NWAVES * 64), LDS_BYTES, stream, a); }
#else
    a.ph_lo = 0; a.ph_hi = N_PHASES;
    void* kargs[] = {&a};
    const hipError_t e = hipLaunchCooperativeKernel((const void*)yoco_fwd, dim3(grid), dim3(NWAVES * 64), kargs, LDS_BYTES, stream);
    if (e != hipSuccess) fprintf(stderr, "kernel_launch: cooperative launch failed: %s (grid %d)\n", hipGetErrorString(e), grid);
#endif
}
```

```cpp
#include <hip/hip_runtime.h>
#include <hip/hip_cooperative_groups.h>
#include <cstdio>
#include <cstdint>
namespace cg = cooperative_groups;
namespace pg8 {
#define PG8_LAS __attribute__((address_space(3)))
typedef unsigned short bf16_t;
typedef short bf16x8 __attribute__((ext_vector_type(8)));
typedef float f32x4 __attribute__((ext_vector_type(4)));
typedef unsigned u32x4 __attribute__((ext_vector_type(4)));
constexpr int BM = 256, BK = 64, HALF = 128, HTB = HALF * BK * 2  , STAGE_BYTES = 8 * HTB, NXCD = 8, WGM = 8;

__host__ __device__ __forceinline__ int lds_byte(int r, int c) { const int st = (r >> 4) * 2 + (c >> 5), rr = r & 15, cc = c & 31, ob = rr * 64 + cc * 2; return st * 1024 + (ob ^ (((ob >> 9) & 1) << 5)); }
__host__ __device__ __forceinline__ void stage_rc(int b, int& R, int& C) { const int st = b / 1024, sb = b % 1024, swz = sb ^ (((sb >> 9) & 1) << 5); R = (st >> 1) * 16 + swz / 64; C = (st & 1) * 32 + (swz % 64) / 2; }
__host__ __device__ __forceinline__ int perm32(int rho) { const int n = rho >> 4, i = rho & 15; return 8 * (i >> 2) + 4 * n + (i & 3); }

struct Unit { int pm, pn; };
struct Gemm { const bf16_t* A; const bf16_t* Bt; int M, N, K; };

struct StaticOrder {
    int nM, nN, nwg, G, c;
    __host__ __device__ void init(int M, int N, int G_, int c_) { nM = M / BM; nN = N / BM; nwg = nM * nN; G = G_; c = c_; }
    __host__ __device__ bool next(int i, Unit& u) const {
        const long L = (long)i * G + c; if (L >= nwg) return false;
        int wgid = (int)L; { const int q = nwg / NXCD, r = nwg % NXCD, xcd = wgid % NXCD, off = wgid / NXCD; wgid = (xcd < r ? xcd * (q + 1) : r * (q + 1) + (xcd - r) * q) + off; }
        const int nig = WGM * nN, gid = wgid / nig, fm = gid * WGM, gsz = (nM - fm) < WGM ? (nM - fm) : WGM;
        u.pm = fm + ((wgid % nig) % gsz); u.pn = (wgid % nig) / gsz; return true;
    }
    __device__ __forceinline__ void a_ready(const Unit&) const {}
    __device__ __forceinline__ void done(const Unit&) const {}
};

__device__ __forceinline__ unsigned cvt_pk_bf16(float lo, float hi) { unsigned r; asm volatile("v_cvt_pk_bf16_f32 %0, %1, %2" : "=v"(r) : "v"(lo), "v"(hi)); return r; }
typedef float f32x2 __attribute__((ext_vector_type(2)));
constexpr int EM = 16384, ED = 1024, EFF = 2816, EDA = 2048, ESEQ = 4096;
constexpr float RMS_EPS = 1e-6f;
__device__ __forceinline__ float silu_mul(float g, float u) { return g * u * __builtin_amdgcn_rcpf(1.f + __builtin_amdgcn_exp2f(-1.4426950409f * g)); }
__device__ __forceinline__ float gelu_tanh(float x) { const float t = x * (2.3022081f + 0.10294324f * x * x); return x * __builtin_amdgcn_rcpf(1.f + __builtin_amdgcn_exp2f(-t)); }
__device__ __forceinline__ float rstd_of(const float* ssq, int row) { return __builtin_amdgcn_rsqf(ssq[row] * (1.0f / 1024.0f) + RMS_EPS); }
__device__ __forceinline__ unsigned short bf16_1(float v) { return (unsigned short)(cvt_pk_bf16(v, 0.f) & 0xffffu); }

struct EpiSwiglu {
    static constexpr bool PERM = true, AFTER_DRAIN = false;
    bf16_t* H; const float* ssq; bf16_t* Kb; bf16_t* VT; int nffn;
    __device__ __forceinline__ void operator()(const f32x4 (&acc)[2][2][4][2], const Unit& u, int wr, int wc, int fr, int fq) const {
        const int row0 = u.pm * BM + wr * 64 + fr;
        if (u.pn < nffn) {
            const int col0 = u.pn * 128 + wc * 32 + 8 * fq;
#pragma unroll
            for (int ai = 0; ai < 2; ++ai)
#pragma unroll
                for (int m = 0; m < 4; ++m) { const int row = row0 + ai * HALF + m * 16; const float rs = rstd_of(ssq, row);
                    const f32x4 g0 = acc[ai][0][m][0] * rs, g1 = acc[ai][0][m][1] * rs, u0 = acc[ai][1][m][0] * rs, u1 = acc[ai][1][m][1] * rs;
                    u32x4 w; w.x = cvt_pk_bf16(silu_mul(g0[0], u0[0]), silu_mul(g0[1], u0[1])); w.y = cvt_pk_bf16(silu_mul(g0[2], u0[2]), silu_mul(g0[3], u0[3]));
                    w.z = cvt_pk_bf16(silu_mul(g1[0], u1[0]), silu_mul(g1[1], u1[1])); w.w = cvt_pk_bf16(silu_mul(g1[2], u1[2]), silu_mul(g1[3], u1[3]));
                    *(u32x4*)(H + (size_t)row * EFF + col0) = w; }
        } else {
            const int isv = u.pn - nffn;
#pragma unroll
            for (int ai = 0; ai < 2; ++ai)
#pragma unroll
                for (int m = 0; m < 4; ++m) { const int row = row0 + ai * HALF + m * 16; const float rs = rstd_of(ssq, row);
#pragma unroll
                    for (int bj = 0; bj < 2; ++bj) { const int col = bj * HALF + wc * 32 + 8 * fq; const f32x4 v0 = acc[ai][bj][m][0] * rs, v1 = acc[ai][bj][m][1] * rs;
                        if (isv == 0) { u32x4 w; w.x = cvt_pk_bf16(v0[0], v0[1]); w.y = cvt_pk_bf16(v0[2], v0[3]); w.z = cvt_pk_bf16(v1[0], v1[1]); w.w = cvt_pk_bf16(v1[2], v1[3]);
                            *(u32x4*)(Kb + (size_t)row * 256 + col) = w; }
                        else { const int b = row >> 12, s = row & (ESEQ - 1), kvh = col >> 6, d0 = col & 63;
                            bf16_t* p = VT + ((size_t)((b * 4 + kvh) * 64 + d0)) * ESEQ + s;
#pragma unroll
                            for (int e = 0; e < 4; ++e) { p[(size_t)e * ESEQ] = bf16_1(v0[e]); p[(size_t)(e + 4) * ESEQ] = bf16_1(v1[e]); } } } }
        }
    }
};
__device__ __forceinline__ float bf_lo(unsigned w) { return __uint_as_float(w << 16); }
__device__ __forceinline__ float bf_hi(unsigned w) { return __uint_as_float(w & 0xffff0000u); }
template <bool SRC_F32> struct EpiResid {
    static constexpr bool PERM = true, AFTER_DRAIN = false;
    const float* src32; bf16_t* xb; float* ssq_out; float scale;
    __device__ __forceinline__ void operator()(const f32x4 (&acc)[2][2][4][2], const Unit& u, int wr, int wc, int fr, int fq) const {
        const int row0 = u.pm * BM + wr * 64 + fr, col0 = u.pn * BM + wc * 32 + 8 * fq;
#pragma unroll
        for (int ai = 0; ai < 2; ++ai)
#pragma unroll
            for (int m = 0; m < 4; ++m) { const int row = row0 + ai * HALF + m * 16; float ss = 0.f;
#pragma unroll
                for (int bj = 0; bj < 2; ++bj) { const size_t off = (size_t)row * ED + col0 + bj * HALF;
                    f32x4 a0, a1;
                    if (SRC_F32) { a0 = *(const f32x4*)(src32 + off); a1 = *(const f32x4*)(src32 + off + 4); }
                    else { const u32x4 r = *(const u32x4*)(xb + off); a0 = (f32x4){bf_lo(r.x), bf_hi(r.x), bf_lo(r.y), bf_hi(r.y)}; a1 = (f32x4){bf_lo(r.z), bf_hi(r.z), bf_lo(r.w), bf_hi(r.w)}; }
                    const f32x4 v0 = a0 + acc[ai][bj][m][0] * scale, v1 = a1 + acc[ai][bj][m][1] * scale;
                    ss += (v0[0] * v0[0] + v0[1] * v0[1]) + (v0[2] * v0[2] + v0[3] * v0[3]) + (v1[0] * v1[0] + v1[1] * v1[1]) + (v1[2] * v1[2] + v1[3] * v1[3]);
                    u32x4 w; w.x = cvt_pk_bf16(v0[0], v0[1]); w.y = cvt_pk_bf16(v0[2], v0[3]); w.z = cvt_pk_bf16(v1[0], v1[1]); w.w = cvt_pk_bf16(v1[2], v1[3]);
                    *(u32x4*)(xb + off) = w; }
                ss += __shfl_xor(ss, 16); ss += __shfl_xor(ss, 32);
                if (fq == 0) unsafeAtomicAdd(ssq_out + row, ss);
                if (m & 1) asm volatile("" ::: "memory"); }
    }
};
template <int ACT> struct EpiRowScale {
    static constexpr bool PERM = true, AFTER_DRAIN = false;
    bf16_t* O; int ldc; const float* ssq; float oscale;
    __device__ __forceinline__ void operator()(const f32x4 (&acc)[2][2][4][2], const Unit& u, int wr, int wc, int fr, int fq) const {
        const int row0 = u.pm * BM + wr * 64 + fr, col0 = u.pn * BM + wc * 32 + 8 * fq;
#pragma unroll
        for (int ai = 0; ai < 2; ++ai)
#pragma unroll
            for (int m = 0; m < 4; ++m) { const int row = row0 + ai * HALF + m * 16; const float rs = rstd_of(ssq, row);
#pragma unroll
                for (int bj = 0; bj < 2; ++bj) { f32x4 v0 = acc[ai][bj][m][0] * rs, v1 = acc[ai][bj][m][1] * rs;
                    if (ACT == 1) {
#pragma unroll
                        for (int e = 0; e < 4; ++e) { v0[e] = gelu_tanh(v0[e]); v1[e] = gelu_tanh(v1[e]); } }
                    v0 = v0 * oscale; v1 = v1 * oscale;
                    u32x4 w; w.x = cvt_pk_bf16(v0[0], v0[1]); w.y = cvt_pk_bf16(v0[2], v0[3]); w.z = cvt_pk_bf16(v1[0], v1[1]); w.w = cvt_pk_bf16(v1[2], v1[3]);
                    *(u32x4*)(O + (size_t)row * ldc + col0 + bj * HALF) = w; } }
    }
};
struct EpiGeluVT {
    static constexpr bool PERM = true, AFTER_DRAIN = false;
    bf16_t* VT; const float* ssq; float* vsum; float* vsq;
    __device__ __forceinline__ void operator()(const f32x4 (&acc)[2][2][4][2], const Unit& u, int wr, int wc, int fr, int fq) const {
        const int row0 = u.pm * BM + wr * 64 + fr, col0 = u.pn * BM + wc * 32 + 8 * fq;
#pragma unroll
        for (int bj = 0; bj < 2; ++bj) {
            float rs[8], cs[8], cq[8];
#pragma unroll
            for (int e = 0; e < 8; ++e) { rs[e] = rstd_of(ssq, col0 + bj * HALF + e); cs[e] = 0.f; cq[e] = 0.f; }
#pragma unroll
            for (int ai = 0; ai < 2; ++ai)
#pragma unroll
                for (int m = 0; m < 4; ++m) { const int row = row0 + ai * HALF + m * 16; float v[8];
#pragma unroll
                    for (int e = 0; e < 4; ++e) { v[e] = gelu_tanh(acc[ai][bj][m][0][e] * rs[e]); v[e + 4] = gelu_tanh(acc[ai][bj][m][1][e] * rs[e + 4]); }
#pragma unroll
                    for (int e = 0; e < 8; ++e) { cs[e] += v[e]; cq[e] += v[e] * v[e]; }
                    u32x4 w; w.x = cvt_pk_bf16(v[0], v[1]); w.y = cvt_pk_bf16(v[2], v[3]); w.z = cvt_pk_bf16(v[4], v[5]); w.w = cvt_pk_bf16(v[6], v[7]);
                    *(u32x4*)(VT + (size_t)row * EM + col0 + bj * HALF) = w; }
#pragma unroll
            for (int e = 0; e < 8; ++e) {
#pragma unroll
                for (int o = 1; o < 16; o <<= 1) { cs[e] += __shfl_xor(cs[e], o); cq[e] += __shfl_xor(cq[e], o); } }
            if (fr == 0) {
#pragma unroll
                for (int e = 0; e < 8; ++e) { unsafeAtomicAdd(vsum + col0 + bj * HALF + e, cs[e]); unsafeAtomicAdd(vsq + col0 + bj * HALF + e, cq[e]); } }
        }
    }
};

template <class Epi, class Sched, bool ALIGN_EPI = false, bool SP2 = false>
__device__ __forceinline__ void gemm_phase(PG8_LAS unsigned char* lds, const Gemm g, const Sched& S, const Epi& E) {
    const int tid = threadIdx.x, wid = __builtin_amdgcn_readfirstlane(tid >> 6), lane = tid & 63, wr = wid >> 2, wc = wid & 3, fr = lane & 15, fq = lane >> 4;
    const int K = g.K, nt = K / BK;
    unsigned voffA[2], voffB[2];
#pragma unroll
    for (int i = 0; i < 2; ++i) { int R, C; stage_rc(tid * 16 + i * 8192, R, C); const int Rb = Epi::PERM ? ((R & ~31) + perm32(R & 31)) : R;
        voffA[i] = (unsigned)(R * K + C) * 2u; voffB[i] = (unsigned)(Rb * K + C) * 2u; }
    const size_t kstep = (size_t)(BK * 2);
    const size_t hstep = (size_t)HALF * K * 2;
    const size_t tstep = 2 * hstep;
    const unsigned ldsw = (unsigned)wid * 1024u;
    const int aoff = lds_byte(wr * 64 + fr, fq * 8), boff = lds_byte(wc * 32 + fr, fq * 8);
#define PG8_SA(b, h) (((b) * 2 + (h)) * HTB)
#define PG8_SB(b, h) ((4 + (b) * 2 + (h)) * HTB)
#define PG8_STAGE(bufoff, gbase, voff) do { _Pragma("unroll") for (int _i = 0; _i < 2; ++_i) \
        __builtin_amdgcn_global_load_lds((const unsigned*)((const char*)(gbase) + (voff)[_i]), (PG8_LAS unsigned*)(lds + (bufoff) + ldsw + _i * 8192), 16, 0, 0); } while (0)
#define PG8_LDA(dst, b, h) do { _Pragma("unroll") for (int m = 0; m < 4; ++m) _Pragma("unroll") for (int k = 0; k < 2; ++k) dst[m][k] = *(const PG8_LAS bf16x8*)(lds + PG8_SA(b, h) + aoff + m * 2048 + k * 1024); } while (0)
#define PG8_LDB(dst, b, h) do { _Pragma("unroll") for (int n = 0; n < 2; ++n) _Pragma("unroll") for (int k = 0; k < 2; ++k) dst[n][k] = *(const PG8_LAS bf16x8*)(lds + PG8_SB(b, h) + boff + n * 2048 + k * 1024); } while (0)
#define PG8_MMA(ai, bj, At, Bt) do { __builtin_amdgcn_s_setprio(1); _Pragma("unroll") for (int m = 0; m < 4; ++m) _Pragma("unroll") for (int n = 0; n < 2; ++n) _Pragma("unroll") for (int k = 0; k < 2; ++k) \
        acc[ai][bj][m][n] = __builtin_amdgcn_mfma_f32_16x16x32_bf16(Bt[n][k], At[m][k], acc[ai][bj][m][n], 0, 0, 0); __builtin_amdgcn_s_setprio(0); } while (0)
#define PG8_WAIT_V(n) asm volatile("s_waitcnt vmcnt(" #n ")" ::: "memory")
#define PG8_WAIT_L(n) asm volatile("s_waitcnt lgkmcnt(" #n ")" ::: "memory")
#define PG8_BAR __builtin_amdgcn_s_barrier()
#define PG8_SCHED __builtin_amdgcn_sched_barrier(0)
    Unit cur, nxt; int ui = 0;
    if (!S.next(0, cur)) return;
    f32x4 acc[2][2][4][2];
#pragma unroll
    for (int a = 0; a < 2; ++a)
#pragma unroll
        for (int b = 0; b < 2; ++b)
#pragma unroll
            for (int m = 0; m < 4; ++m)
#pragma unroll
                for (int n = 0; n < 2; ++n) acc[a][b][m][n] = (f32x4){0.f, 0.f, 0.f, 0.f};
    bf16x8 At[4][2], B0[2][2], B1[2][2];
    const char* cA = (const char*)g.A + (size_t)cur.pm * tstep; const char* cB = (const char*)g.Bt + (size_t)cur.pn * tstep;
    S.a_ready(cur);
    if constexpr (SP2) {
        PG8_STAGE(PG8_SB(0, 0), cB, voffB); PG8_STAGE(PG8_SB(0, 1), cB + hstep, voffB); PG8_STAGE(PG8_SA(0, 0), cA, voffA); PG8_STAGE(PG8_SA(0, 1), cA + hstep, voffA);
        if (wr == 1) PG8_BAR;
        PG8_WAIT_V(2); PG8_BAR;
        PG8_STAGE(PG8_SB(1, 0), cB + kstep, voffB); PG8_STAGE(PG8_SA(1, 0), cA + kstep, voffA); PG8_STAGE(PG8_SB(1, 1), cB + hstep + kstep, voffB);
        PG8_WAIT_V(6); PG8_BAR;
    } else {
        PG8_STAGE(PG8_SB(0, 0), cB, voffB); PG8_STAGE(PG8_SA(0, 0), cA, voffA); PG8_STAGE(PG8_SB(0, 1), cB + hstep, voffB); PG8_STAGE(PG8_SA(0, 1), cA + hstep, voffA);
        if (wr == 1) PG8_BAR;
        PG8_WAIT_V(4); PG8_BAR;
        PG8_STAGE(PG8_SB(1, 0), cB + kstep, voffB); PG8_STAGE(PG8_SA(1, 0), cA + kstep, voffA); PG8_STAGE(PG8_SB(1, 1), cB + hstep + kstep, voffB);
        PG8_WAIT_V(6); PG8_BAR;
    }
    for (;;) {
        const bool has_next = S.next(ui + 1, nxt);
        const char* nA = has_next ? (const char*)g.A + (size_t)nxt.pm * tstep : cA; const char* nB = has_next ? (const char*)g.Bt + (size_t)nxt.pn * tstep : cB;
        for (int t = 0; t < nt; t += 2) {
            const bool last = (t == nt - 2);
            const char* a1 = cA + (size_t)(t + 1) * kstep;
            const char* a2 = last ? nA : cA + (size_t)(t + 2) * kstep; const char* b2 = last ? nB : cB + (size_t)(t + 2) * kstep;
            const char* a3 = a2 + kstep; const char* b3 = b2 + kstep;
            if (last && has_next) S.a_ready(nxt);
            if constexpr (SP2) {
            PG8_LDB(B0, 0, 0); PG8_LDB(B1, 0, 1); PG8_SCHED; PG8_LDA(At, 0, 0); PG8_STAGE(PG8_SA(1, 1), a1 + hstep, voffA);
            PG8_WAIT_V(8); PG8_WAIT_L(0); PG8_BAR; PG8_MMA(0, 0, At, B0); PG8_MMA(0, 1, At, B1); PG8_BAR; PG8_SCHED;
            PG8_LDA(At, 0, 1); PG8_STAGE(PG8_SB(0, 0), b2, voffB); PG8_STAGE(PG8_SB(0, 1), b2 + hstep, voffB); PG8_STAGE(PG8_SA(0, 0), a2, voffA);
            PG8_WAIT_V(8); PG8_WAIT_L(0); PG8_BAR; PG8_MMA(1, 0, At, B0); PG8_MMA(1, 1, At, B1); PG8_BAR; PG8_SCHED;
            PG8_LDB(B0, 1, 0); PG8_LDB(B1, 1, 1); PG8_SCHED; PG8_LDA(At, 1, 0); PG8_STAGE(PG8_SA(0, 1), a2 + hstep, voffA);
            PG8_WAIT_V(8); PG8_WAIT_L(0); PG8_BAR; PG8_MMA(0, 0, At, B0); PG8_MMA(0, 1, At, B1); PG8_BAR; PG8_SCHED;
            PG8_LDA(At, 1, 1); PG8_STAGE(PG8_SB(1, 0), b3, voffB); PG8_STAGE(PG8_SB(1, 1), b3 + hstep, voffB); PG8_STAGE(PG8_SA(1, 0), a3, voffA);
            PG8_WAIT_V(8); PG8_WAIT_L(0); PG8_BAR; PG8_MMA(1, 0, At, B0); PG8_MMA(1, 1, At, B1); PG8_BAR; PG8_SCHED;
            } else {
            PG8_LDB(B0, 0, 0); PG8_SCHED; PG8_LDA(At, 0, 0); PG8_STAGE(PG8_SA(1, 1), a1 + hstep, voffA);
            PG8_WAIT_L(8); PG8_BAR; PG8_WAIT_L(0); PG8_MMA(0, 0, At, B0); PG8_BAR; PG8_SCHED;
            PG8_LDB(B1, 0, 1); PG8_STAGE(PG8_SB(0, 0), b2, voffB);
            PG8_BAR; PG8_WAIT_L(0); PG8_MMA(0, 1, At, B1); PG8_BAR;
            PG8_LDA(At, 0, 1); PG8_STAGE(PG8_SA(0, 0), a2, voffA);
            PG8_BAR; PG8_WAIT_L(0); PG8_MMA(1, 0, At, B0); PG8_BAR; PG8_SCHED;
            PG8_STAGE(PG8_SB(0, 1), b2 + hstep, voffB);
            PG8_WAIT_V(6); PG8_BAR; PG8_MMA(1, 1, At, B1); PG8_BAR;
            PG8_LDB(B0, 1, 0); PG8_SCHED; PG8_LDA(At, 1, 0); PG8_STAGE(PG8_SA(0, 1), a2 + hstep, voffA);
            PG8_WAIT_L(8); PG8_BAR; PG8_WAIT_L(0); PG8_MMA(0, 0, At, B0); PG8_BAR; PG8_SCHED;
            PG8_LDB(B1, 1, 1); PG8_STAGE(PG8_SB(1, 0), b3, voffB);
            PG8_BAR; PG8_WAIT_L(0); PG8_MMA(0, 1, At, B1); PG8_BAR;
            PG8_LDA(At, 1, 1); PG8_STAGE(PG8_SA(1, 0), a3, voffA);
            PG8_BAR; PG8_WAIT_L(0); PG8_MMA(1, 0, At, B0); PG8_BAR; PG8_SCHED;
            PG8_STAGE(PG8_SB(1, 1), b3 + hstep, voffB);
            PG8_WAIT_V(6); PG8_BAR; PG8_MMA(1, 1, At, B1); PG8_BAR;
            }
        }
        if constexpr (ALIGN_EPI) { if (wr == 0) PG8_BAR; }
        if constexpr (!Epi::AFTER_DRAIN) { E(acc, cur, wr, wc, fr, fq); S.done(cur); }
        if (!has_next) break;
#pragma unroll
        for (int a = 0; a < 2; ++a)
#pragma unroll
            for (int b = 0; b < 2; ++b)
#pragma unroll
                for (int m = 0; m < 4; ++m)
#pragma unroll
                    for (int n = 0; n < 2; ++n) acc[a][b][m][n] = (f32x4){0.f, 0.f, 0.f, 0.f};
        cur = nxt; cA = nA; cB = nB; ++ui;
        if constexpr (ALIGN_EPI) { if (wr == 1) PG8_BAR; }
    }
    PG8_WAIT_V(0);
    if constexpr (!ALIGN_EPI) { if (wr == 0) PG8_BAR; }
    PG8_BAR;
    if constexpr (Epi::AFTER_DRAIN) { E.fused(acc, cur, wr, wc, fr, fq, lds, wid, lane); S.done(cur); }
#undef PG8_SA
#undef PG8_SB
#undef PG8_STAGE
#undef PG8_LDA
#undef PG8_LDB
#undef PG8_MMA
#undef PG8_WAIT_V
#undef PG8_WAIT_L
#undef PG8_BAR
#undef PG8_SCHED
}
}
constexpr int NWAVES = 8;
constexpr int M = 16384, D = 1024, DFF = 2816, DA = 2048, SEQ = 4096, NBATCH = 4;
constexpr int NIN_FFN = 2 * DFF;
constexpr int NIN_KV = NIN_FFN + 512;
#ifndef MK_PER_PHASE
#define MK_PER_PHASE 0
#endif
constexpr int N_PHASES = 16;
#ifndef PROBE_PHASE
#define PROBE_PHASE -1
#endif

constexpr size_t MiB = 1u << 20;
constexpr size_t WS_CTL = 0, CTL_ZERO_BYTES = 1 * MiB;
constexpr size_t WS_WIN = 2 * MiB;
constexpr size_t WIN_STRIDE = 12 * MiB;
constexpr size_t WS_WOUT = WS_WIN + 4 * WIN_STRIDE;
constexpr size_t WOUT_STRIDE = 6 * MiB;
constexpr size_t WS_AIN = WS_WOUT + 4 * WOUT_STRIDE;
constexpr size_t WS_AOUT = WS_AIN + 8 * MiB;
constexpr size_t WS_WQ = WS_AOUT + 4 * MiB;
constexpr size_t WS_WO = WS_WQ + 2 * MiB;
constexpr size_t WS_XB = WS_WO + 2 * MiB;
constexpr size_t WS_H = WS_XB + 32 * MiB;
constexpr size_t WS_R2 = WS_H + 88 * MiB;
constexpr size_t WS_UV = WS_R2 + 64 * MiB;
constexpr size_t WS_END = WS_UV + 64 * MiB;
constexpr int CW_BAR = 4096;
constexpr int CW_SSQ = 16384;
constexpr int CW_VSUM = CW_SSQ + 7 * M, CW_VSQ = CW_VSUM + M;
static_assert((size_t)(CW_VSQ + M) * 4 <= CTL_ZERO_BYTES, "CTL words inside the memset region");

constexpr int RING_OFF = 0, RING_BYTES = 131072;
constexpr int LDSCTL_OFF = RING_BYTES, MISC_OFF = LDSCTL_OFF + 320;
constexpr int LDS_BYTES = 147456;

#define GAS __attribute__((address_space(1)))
#define LAS __attribute__((address_space(3)))
typedef unsigned short bf16;
typedef unsigned v4u __attribute__((ext_vector_type(4)));
typedef float f32x4 __attribute__((ext_vector_type(4)));
typedef short bf16x8 __attribute__((ext_vector_type(8)));
typedef GAS unsigned gu32;
typedef GAS unsigned long long gu64;
#define RLX_AGENT __ATOMIC_RELAXED, __HIP_MEMORY_SCOPE_AGENT
#define LDS_WAIT() asm volatile("s_waitcnt lgkmcnt(0)" ::: "memory")
#define VM_WAIT() asm volatile("s_waitcnt vmcnt(0)" ::: "memory")
__device__ __forceinline__ unsigned long long rt() { return __builtin_amdgcn_s_memrealtime(); }
__device__ __forceinline__ unsigned f2bf(float f) { unsigned u = __builtin_bit_cast(unsigned, f); return (u + 0x7fffu + ((u >> 16) & 1u)) >> 16; }
__device__ __forceinline__ unsigned pk2(float lo, float hi) { return f2bf(lo) | (f2bf(hi) << 16); }

#define XB_TMO      128
#define XB_XCNT(j)  (256  + 64 * (j))
#define XB_XSUB(j)  (1280 + 64 * (j))
#define XB_XGEN(j)  (2304 + 64 * (j))
#define XB_TOP      3328
#define XB_TOPGEN   3392
#define XCD_BAR_WORDS 3456
#define XB_SPIN_CAP (1u << 18)

__device__ __forceinline__ unsigned xb_ld(unsigned* p)              { return __hip_atomic_load(p, __ATOMIC_RELAXED, __HIP_MEMORY_SCOPE_AGENT); }
__device__ __forceinline__ unsigned xb_add(unsigned* p, unsigned v) { return __hip_atomic_fetch_add(p, v, __ATOMIC_RELAXED, __HIP_MEMORY_SCOPE_AGENT); }
__device__ __forceinline__ unsigned xb_xcc_id() { return (unsigned)__builtin_amdgcn_s_getreg((3 << 11) | 20) & 0xFu; }
#define XB_SPIN(cond, bar) do { unsigned _sp = 0; while (cond) { __builtin_amdgcn_s_sleep(1); \
    if ((++_sp & 255u) == 0u) { if (xb_ld(&(bar)[XB_TMO])) break; if (_sp > XB_SPIN_CAP) { atomicAdd(&(bar)[XB_TMO], 1u); break; } } } } while (0)

struct XcdBarrier {
    unsigned* bar; unsigned x;
    volatile LAS unsigned* st;
};

__device__ __forceinline__ XcdBarrier xcd_barrier_post(unsigned* bar, volatile LAS unsigned* st) {
    XcdBarrier b; b.bar = bar; b.x = xb_xcc_id(); b.st = st;
    if (threadIdx.x == 0) (void)xb_add(&bar[XB_XCNT(b.x)], 1u);
    return b;
}
__device__ __forceinline__ void xcd_barrier_complete(unsigned* bar, unsigned x, unsigned& nloc, unsigned& nx) {
    const unsigned G = gridDim.x * gridDim.y * gridDim.z;
    unsigned sum, cnt, mine, sp = 0u;
    for (;;) {
        sum = 0u; cnt = 0u; mine = 0u;
#pragma unroll
        for (unsigned j = 0; j < 16; ++j) { const unsigned c = xb_ld(&bar[XB_XCNT(j)]); sum += c; cnt += (c > 0u) ? 1u : 0u; mine = (j == x) ? c : mine; }
        if (sum == G) break;
        __builtin_amdgcn_s_sleep(1);
        if ((++sp & 255u) == 0u) { if (xb_ld(&bar[XB_TMO])) break; if (sp > XB_SPIN_CAP) { atomicAdd(&bar[XB_TMO], 1u); break; } }
    }
    nloc = mine > 0u ? mine : 1u; nx = cnt > 0u ? cnt : 1u;
}

__device__ __forceinline__ void xcd_barrier(const XcdBarrier& b) {
    asm volatile("s_waitcnt vmcnt(0)" ::: "memory");
    __syncthreads();
    if (threadIdx.x == 0) {
        unsigned* bar = b.bar;
        __builtin_amdgcn_s_waitcnt(0);
        unsigned nloc = b.st[0], nx = b.st[1];
        if (nloc == 0u) { xcd_barrier_complete(bar, b.x, nloc, nx); b.st[0] = nloc; b.st[1] = nx; }
        const unsigned old = xb_add(&bar[XB_XSUB(b.x)], 1u);
        const unsigned gen = old / nloc;
        if (old + 1u == (gen + 1u) * nloc) {
            __builtin_amdgcn_fence(__ATOMIC_RELEASE, "agent");
            asm volatile("s_waitcnt vmcnt(0)" ::: "memory");
            const unsigned og = xb_add(&bar[XB_TOP], 1u);
            const unsigned tg = og / nx;
            if (og + 1u == (tg + 1u) * nx) xb_add(&bar[XB_TOPGEN], 1u);
            else XB_SPIN(xb_ld(&bar[XB_TOPGEN]) == tg, bar);
            __builtin_amdgcn_fence(__ATOMIC_ACQUIRE, "agent");
            xb_add(&bar[XB_XGEN(b.x)], 1u);
            asm volatile("s_waitcnt vmcnt(0)" ::: "memory");
        } else {
            XB_SPIN(xb_ld(&bar[XB_XGEN(b.x)]) == gen, bar);
            __builtin_amdgcn_fence(__ATOMIC_ACQUIRE, "agent");
            asm volatile("s_waitcnt vmcnt(0)" ::: "memory");
        }
    }
    __syncthreads();
}
typedef float f32x16 __attribute__((ext_vector_type(16)));
typedef short s16x4 __attribute__((ext_vector_type(4)));
typedef unsigned v2u __attribute__((ext_vector_type(2)));
typedef float f32x2_t __attribute__((ext_vector_type(2))); typedef __bf16 bf16x2_t __attribute__((ext_vector_type(2)));
__device__ __forceinline__ unsigned cvtpk(float lo, float hi) { f32x2_t v = {lo, hi}; bf16x2_t b = __builtin_convertvector(v, bf16x2_t); return __builtin_bit_cast(unsigned, b); }
__device__ __forceinline__ float bflo(unsigned w) { return __uint_as_float(w << 16); }
__device__ __forceinline__ float bfhi(unsigned w) { return __uint_as_float(w & 0xffff0000u); }

struct Frame {
    LAS unsigned char* lds;
    volatile LAS unsigned* MISC;
    gu32* ctl;
    int tid, lane, wave;
    int vcu, G;
};
__device__ __forceinline__ float wave_sum(float v) {
#pragma unroll
    for (int o = 1; o < 64; o <<= 1) v += __shfl_xor(v, o);
    return v;
}
__device__ __forceinline__ void p0_item(const float* W, int ldn, int K, int nblk, bf16* WT, const float* gk, int mode, LAS float* scr, int item, int lane) {
    const int kb = item / nblk, nb = item % nblk, k0 = 64 * kb, n0 = 32 * nb;
    const int rowb = (mode == 0) ? n0 : (256 * (n0 >> 7) + (n0 & 127) + (mode == 2 ? 128 : 0));
    const int kr = lane >> 3, n4 = (lane & 7) * 4;
    f32x4 w[8];
#pragma unroll
    for (int i = 0; i < 8; ++i) w[i] = *(const GAS f32x4*)(W + (size_t)(k0 + i * 8 + kr) * ldn + n0 + n4);
    if (gk) {
#pragma unroll
        for (int i = 0; i < 8; ++i) w[i] = w[i] * gk[k0 + i * 8 + kr]; }
#pragma unroll
    for (int i = 0; i < 8; ++i) { LAS float* d = scr + (i * 8 + kr) * 33 + n4; d[0] = w[i].x; d[1] = w[i].y; d[2] = w[i].z; d[3] = w[i].w; }
    LDS_WAIT(); asm volatile("" ::: "memory");
    const int c = lane & 7;
#pragma unroll
    for (int j = 0; j < 4; ++j) { const int n = (lane >> 3) + 8 * j; const LAS float* s = scr + (8 * c) * 33 + n;
        v4u o; o.x = pk2(s[0 * 33], s[1 * 33]); o.y = pk2(s[2 * 33], s[3 * 33]); o.z = pk2(s[4 * 33], s[5 * 33]); o.w = pk2(s[6 * 33], s[7 * 33]);
        *(GAS v4u*)(WT + (size_t)(rowb + n) * K + k0 + 8 * c) = o; }
    LDS_WAIT(); asm volatile("" ::: "memory");
}
struct Ptrs {
    const float *x, *ffn_norm, *ffn_w_in, *ffn_w_out, *mix_norm, *a_w_in, *a_ln_g, *a_ln_b, *a_w_s, *a_b_s, *a_w_out, *kv_norm, *w_kv, *b_w_q, *b_w_o, *final_norm;
    float* X;
    bf16 *WIN, *WOUT, *AIN, *AOUT, *WQ, *WO, *XB, *H, *U, *UV, *O, *VTs, *Q, *Kb, *VTa;
    float *ssq, *vsum, *vsq;
};
__device__ __forceinline__ void p0_prologue(Frame& F, const Ptrs& P) {
    LAS float* scr = (LAS float*)(F.lds + RING_OFF + F.wave * 16384);
    const int gw = F.vcu * NWAVES + F.wave, NGW = F.G * NWAVES;
    constexpr int I_IN = 16 * (DFF / 32);
    constexpr int I_KV = 16 * (512 / 32);
    constexpr int I_OUT = (DFF / 64) * (D / 32);
    constexpr int I_AIN = 16 * (2 * DA / 32);
    constexpr int I_AOUT = (DA / 64) * (D / 32);
    constexpr int I_Q = 16 * 32;
    constexpr int NITEMS = 8 * I_IN + I_KV + 4 * I_OUT + I_AIN + I_AOUT + 2 * I_Q;
    for (int it = gw; it < NITEMS; it += NGW) {
        int r = it;
        if (r < 8 * I_IN) { const int mat = r / (2 * I_IN), rr = r % (2 * I_IN), up = rr / I_IN, item = rr % I_IN;
            p0_item(P.ffn_w_in + (size_t)mat * D * NIN_FFN + up * DFF, NIN_FFN, D, DFF / 32, (bf16*)((char*)P.WIN + mat * WIN_STRIDE), P.ffn_norm + mat * D, 1 + up, scr, item, F.lane); continue; }
        r -= 8 * I_IN;
        if (r < I_KV) { p0_item(P.w_kv, 512, D, 16, (bf16*)((char*)P.WIN + 2 * WIN_STRIDE) + (size_t)NIN_FFN * D, P.kv_norm, 0, scr, r, F.lane); continue; }
        r -= I_KV;
        if (r < 4 * I_OUT) { const int mat = r / I_OUT, item = r % I_OUT;
            p0_item(P.ffn_w_out + (size_t)mat * DFF * D, D, DFF, D / 32, (bf16*)((char*)P.WOUT + mat * WOUT_STRIDE), nullptr, 0, scr, item, F.lane); continue; }
        r -= 4 * I_OUT;
        if (r < I_AIN) { p0_item(P.a_w_in, 2 * DA, D, 2 * DA / 32, P.AIN, P.mix_norm, 0, scr, r, F.lane); continue; }
        r -= I_AIN;
        if (r < I_AOUT) { p0_item(P.a_w_out, D, DA, D / 32, P.AOUT, nullptr, 0, scr, r, F.lane); continue; }
        r -= I_AOUT;
        if (r < I_Q) { p0_item(P.b_w_q, D, D, D / 32, P.WQ, P.mix_norm + D, 0, scr, r, F.lane); continue; }
        r -= I_Q;
        p0_item(P.b_w_o, D, D, D / 32, P.WO, nullptr, 0, scr, r, F.lane);
    }
    for (int m = gw; m < M; m += NGW) {
        const GAS f32x4* xr = (const GAS f32x4*)(P.x + (size_t)m * D) + F.lane;
        f32x4 v[4]; float s = 0.f;
#pragma unroll
        for (int j = 0; j < 4; ++j) { v[j] = xr[64 * j]; s += (v[j].x * v[j].x + v[j].y * v[j].y) + (v[j].z * v[j].z + v[j].w * v[j].w); }
        s = wave_sum(s);
        GAS unsigned long long* o8 = (GAS unsigned long long*)(P.XB + (size_t)m * D) + F.lane;
#pragma unroll
        for (int j = 0; j < 4; ++j) o8[64 * j] = (unsigned long long)pk2(v[j].x, v[j].y) | ((unsigned long long)pk2(v[j].z, v[j].w) << 32);
        if (F.lane == 0) P.ssq[m] = s;
    }
}
__device__ __forceinline__ void final_norm_phase(Frame& F, const Ptrs& P) {
    const int gw = F.vcu * NWAVES + F.wave, NGW = F.G * NWAVES;
    f32x4 g0[2], g1[2];
#pragma unroll
    for (int j = 0; j < 2; ++j) { g0[j] = ((const GAS f32x4*)P.final_norm)[2 * F.lane + 128 * j]; g1[j] = ((const GAS f32x4*)P.final_norm)[2 * F.lane + 128 * j + 1]; }
    for (int m = gw; m < M; m += NGW) {
        const float rs = __builtin_amdgcn_rsqf(P.ssq[6 * M + m] * (1.0f / 1024.0f) + 1e-6f);
#pragma unroll
        for (int j = 0; j < 2; ++j) { const v4u r = ((const GAS v4u*)(P.XB + (size_t)m * D))[F.lane + 64 * j];
            GAS f32x4* o = (GAS f32x4*)(P.X + (size_t)m * D) + 2 * F.lane + 128 * j;
            o[0] = (f32x4){bflo(r.x), bfhi(r.x), bflo(r.y), bfhi(r.y)} * rs * g0[j]; o[1] = (f32x4){bflo(r.z), bfhi(r.z), bflo(r.w), bfhi(r.w)} * rs * g1[j]; }
    }
}

constexpr int SG_WM = 0, SG_LD = 272, SG_BT = 128 * SG_LD  , SG_CLD = 528, SG_STAT = SG_BT + 256 * SG_LD  ;
static_assert(128 * SG_CLD <= 256 * SG_LD && SG_STAT + 1024 <= RING_BYTES, "sgu LDS map");
__device__ __forceinline__ void sgu_phase(Frame& F, const Ptrs& P) {
    LAS unsigned char* lds = F.lds + RING_OFF;
    const int tid = F.tid, lane = F.lane, wid = F.wave, fr = lane & 15, fq = lane >> 4, wt = wid >> 2, wc = wid & 3;
    const int s8 = (tid & 15) * 8, crow0 = tid >> 4;
    int gload = -1;
    v4u vraw[8]; float st_sum = 0.f, st_sq = 0.f;
#define SG_PREFETCH(unx) do { const int g_ = (unx) & 7, tok_ = ((unx) >> 3) * 128; \
        _Pragma("unroll") for (int i = 0; i < 8; ++i) vraw[i] = *(const GAS v4u*)(P.VTs + (size_t)(g_ * 256 + i * 32 + crow0) * M + tok_ + s8); \
        if (tid < 128) { st_sum = P.vsum[tok_ + tid]; st_sq = P.vsq[tok_ + tid]; } } while (0)
    if (F.vcu < 1024) SG_PREFETCH(F.vcu);
    for (int un = F.vcu; un < 1024; un += F.G) {
        const int g = un & 7, chunk = un >> 3, tok0 = chunk * 128;
        __syncthreads();
        if (g != gload) {
            const float* ws = P.a_w_s + (size_t)g * 128 * 128;
#pragma unroll
            for (int i = 0; i < 4; ++i) { const int idx = i * 512 + tid, t = idx >> 4, sb = (idx & 15) * 8;
                const f32x4 a = *(const GAS f32x4*)(ws + t * 128 + sb), b = *(const GAS f32x4*)(ws + t * 128 + sb + 4);
                float v[8] = {a.x, a.y, a.z, a.w, b.x, b.y, b.z, b.w};
#pragma unroll
                for (int e = 0; e < 8; ++e) v[e] = (sb + e <= t) ? v[e] : 0.f;
                v4u o; o.x = cvtpk(v[0], v[1]); o.y = cvtpk(v[2], v[3]); o.z = cvtpk(v[4], v[5]); o.w = cvtpk(v[6], v[7]);
                *(LAS v4u*)(lds + SG_WM + t * SG_LD + sb * 2) = o; }
            gload = g;
        }
        if (tid < 128) { const float mean = st_sum * (1.0f / 2048.0f); const float var = fmaxf(st_sq * (1.0f / 2048.0f) - mean * mean, 0.f);
            ((LAS float*)(lds + SG_STAT))[tid] = mean; ((LAS float*)(lds + SG_STAT))[128 + tid] = __builtin_amdgcn_rsqf(var + 1e-5f); }
        __syncthreads();
        {
            float mu[8], rsd[8];
#pragma unroll
            for (int e = 0; e < 8; ++e) { mu[e] = ((LAS float*)(lds + SG_STAT))[s8 + e]; rsd[e] = ((LAS float*)(lds + SG_STAT))[128 + s8 + e]; }
#pragma unroll
            for (int i = 0; i < 8; ++i) { const int c = i * 32 + crow0, cgl = g * 256 + c;
                const v4u w = vraw[i]; const float lg = P.a_ln_g[cgl], lb = P.a_ln_b[cgl];
                float v[8] = {bflo(w.x), bfhi(w.x), bflo(w.y), bfhi(w.y), bflo(w.z), bfhi(w.z), bflo(w.w), bfhi(w.w)};
#pragma unroll
                for (int e = 0; e < 8; ++e) v[e] = (v[e] - mu[e]) * rsd[e] * lg + lb;
                v4u o; o.x = cvtpk(v[0], v[1]); o.y = cvtpk(v[2], v[3]); o.z = cvtpk(v[4], v[5]); o.w = cvtpk(v[6], v[7]);
                *(LAS v4u*)(lds + SG_BT + c * SG_LD + s8 * 2) = o; }
        }
        __syncthreads();
        v4u ureg[8];
#pragma unroll
        for (int i = 0; i < 8; ++i) { const int idx = i * 512 + tid, t = idx >> 5, c8 = (idx & 31) * 8; ureg[i] = *(const GAS v4u*)(P.U + (size_t)(tok0 + t) * DA + g * 256 + c8); }
        if (un + F.G < 1024) SG_PREFETCH(un + F.G);
        f32x4 acc[4][4];
#pragma unroll
        for (int a = 0; a < 4; ++a)
#pragma unroll
            for (int b = 0; b < 4; ++b) acc[a][b] = (f32x4){0.f, 0.f, 0.f, 0.f};
#pragma unroll
        for (int ks = 0; ks < 4; ++ks) { bf16x8 af[4], bfr[4];
#pragma unroll
            for (int i = 0; i < 4; ++i) { af[i] = *(const LAS bf16x8*)(lds + SG_WM + (wt * 64 + i * 16 + fr) * SG_LD + (ks * 32 + fq * 8) * 2);
                                          bfr[i] = *(const LAS bf16x8*)(lds + SG_BT + (wc * 64 + i * 16 + fr) * SG_LD + (ks * 32 + fq * 8) * 2); }
#pragma unroll
            for (int mt = 0; mt < 4; ++mt)
#pragma unroll
                for (int nt = 0; nt < 4; ++nt) acc[mt][nt] = __builtin_amdgcn_mfma_f32_16x16x32_bf16(bfr[nt], af[mt], acc[mt][nt], 0, 0, 0); }
        __syncthreads();
#pragma unroll
        for (int mt = 0; mt < 4; ++mt) { const int t = wt * 64 + mt * 16 + fr; const float bs = P.a_b_s[g * 128 + t];
#pragma unroll
            for (int nt = 0; nt < 4; ++nt) { const int c = wc * 64 + nt * 16 + 4 * fq; const f32x4 v = acc[mt][nt] + bs;
                v2u o; o.x = cvtpk(v[0], v[1]); o.y = cvtpk(v[2], v[3]); *(LAS v2u*)(lds + SG_BT + t * SG_CLD + c * 2) = o; } }
        __syncthreads();
#pragma unroll
        for (int i = 0; i < 8; ++i) { const int idx = i * 512 + tid, t = idx >> 5, c8 = (idx & 31) * 8;
            const v4u cw = *(const LAS v4u*)(lds + SG_BT + t * SG_CLD + c8 * 2); const v4u uw = ureg[i];
            v4u o; o.x = cvtpk(bflo(cw.x) * bflo(uw.x), bfhi(cw.x) * bfhi(uw.x)); o.y = cvtpk(bflo(cw.y) * bflo(uw.y), bfhi(cw.y) * bfhi(uw.y));
            o.z = cvtpk(bflo(cw.z) * bflo(uw.z), bfhi(cw.z) * bfhi(uw.z)); o.w = cvtpk(bflo(cw.w) * bflo(uw.w), bfhi(cw.w) * bfhi(uw.w));
            *(GAS v4u*)(P.UV + (size_t)(tok0 + t) * DA + g * 256 + c8) = o; }
    }
#undef SG_PREFETCH
    __syncthreads();
}

constexpr int AT_K = 0, AT_KLD = 144, AT_V = 64 * AT_KLD  , AT_VLD = 136, AT_FLAG = AT_V + 64 * AT_VLD  ;
constexpr float SB_LIVE = 1.0e-43f;
__device__ __forceinline__ int crow(int r, int hi) { return (r & 3) + 8 * (r >> 2) + 4 * hi; }
template <bool MASKED> __device__ __forceinline__ void sb_block(f32x16& p, float& carry, int hi, int qloc, unsigned (&pk)[8]) {
    float om[16];
#pragma unroll
    for (int i = 0; i < 16; ++i) { om[i] = __builtin_amdgcn_rcpf(1.f + __builtin_amdgcn_exp2f(p[i])); if (MASKED) { if (!(crow(i, hi) < qloc)) om[i] = 1.f; } }
    float gp[4], pg[4];
#pragma unroll
    for (int g = 0; g < 4; ++g) gp[g] = (om[4 * g] * om[4 * g + 1]) * (om[4 * g + 2] * om[4 * g + 3]);
#pragma unroll
    for (int g = 0; g < 4; ++g) pg[g] = __shfl_xor(gp[g], 32);
    const float t0 = gp[0] * pg[0], t1 = gp[1] * pg[1], t2 = gp[2] * pg[2], t3 = gp[3] * pg[3];
    float above[4]; above[3] = 1.f; above[2] = t3; above[1] = t3 * t2; above[0] = above[1] * t1;
    const float total = above[0] * t0;
#pragma unroll
    for (int g = 0; g < 4; ++g) { float c = carry * above[g] * (hi == 0 ? pg[g] : 1.f);
#pragma unroll
        for (int e = 3; e >= 0; --e) { const int i = 4 * g + e; p[i] = (1.f - om[i]) * c; c *= om[i]; } }
    carry *= total;
#pragma unroll
    for (int j = 0; j < 8; ++j) pk[j] = cvtpk(p[2 * j], p[2 * j + 1]);
}
__device__ __forceinline__ void attn_phase(Frame& F, const Ptrs& P) {
    LAS unsigned char* lds = F.lds + RING_OFF;
    volatile LAS unsigned* flag = (volatile LAS unsigned*)(lds + AT_FLAG);
    const int tid = F.tid, lane = F.lane, wid = F.wave, r32 = lane & 31, hi = lane >> 5, half = wid & 1;
    const int lr = tid >> 3, lc8 = (tid & 7) * 8;
    for (int un = F.vcu; un < 1024; un += F.G) {
        const int bk = un & 15, qb = un >> 4, b = bk >> 2, kvh = bk & 3, hq = kvh * 4 + (wid >> 1);
        const size_t qrow = (size_t)b * SEQ + qb * 64 + half * 32 + r32;
        const bf16* kbase = P.Kb + ((size_t)b * SEQ + lr) * 256 + kvh * 64 + lc8;
        const bf16* vbase = P.VTa + ((size_t)(bk * 64 + lr)) * SEQ + lc8;
        v4u kw = *(const GAS v4u*)(kbase + (size_t)qb * 64 * 256), vw = *(const GAS v4u*)(vbase + qb * 64);
        bf16x8 qr[4];
#pragma unroll
        for (int d0 = 0; d0 < 4; ++d0) qr[d0] = *(const GAS bf16x8*)(P.Q + qrow * D + hq * 64 + d0 * 16 + hi * 8);
        f32x16 o0, o1;
#pragma unroll
        for (int i = 0; i < 16; ++i) { o0[i] = 0.f; o1[i] = 0.f; }
        float carry = 1.f; bool active = true; int it = 0;
        for (int kt = qb; kt >= 0; --kt, ++it) {
            __syncthreads();
            if (it > 0) { if (flag[(it - 1) & 1] == 0u) break; }
            if (tid == 0) flag[it & 1] = 0u;
            *(LAS v4u*)(lds + AT_K + lr * AT_KLD + lc8 * 2) = kw;
            *(LAS v2u*)(lds + AT_V + lr * AT_VLD + lc8 * 2) = (v2u){vw.x, vw.y}; *(LAS v2u*)(lds + AT_V + lr * AT_VLD + lc8 * 2 + 8) = (v2u){vw.z, vw.w};
            if (kt > 0) { kw = *(const GAS v4u*)(kbase + (size_t)(kt - 1) * 64 * 256); vw = *(const GAS v4u*)(vbase + (kt - 1) * 64); }
            __syncthreads();
            if (active) {
                const bool diag = (kt == qb);
#pragma unroll
                for (int blk = 1; blk >= 0; --blk) {
                    if (diag && blk > half) continue;
                    f32x16 p;
#pragma unroll
                    for (int i = 0; i < 16; ++i) p[i] = 0.f;
#pragma unroll
                    for (int d0 = 0; d0 < 4; ++d0) { const bf16x8 kf = *(const LAS bf16x8*)(lds + AT_K + (blk * 32 + r32) * AT_KLD + (d0 * 16 + hi * 8) * 2);
                        p = __builtin_amdgcn_mfma_f32_32x32x16_bf16(kf, qr[d0], p, 0, 0, 0); }
                    unsigned pk[8];
                    if (diag && blk == half) sb_block<true>(p, carry, hi, r32, pk); else sb_block<false>(p, carry, hi, r32, pk);
#pragma unroll
                    for (int s = 0; s < 2; ++s) { const bf16x8 pf = __builtin_bit_cast(bf16x8, (v4u){pk[4 * s], pk[4 * s + 1], pk[4 * s + 2], pk[4 * s + 3]});
#pragma unroll
                        for (int db = 0; db < 2; ++db) { const LAS unsigned char* vp = lds + AT_V + (db * 32 + r32) * AT_VLD + (blk * 32 + 16 * s + 4 * hi) * 2;
                            const v2u lo = *(const LAS v2u*)vp, hh = *(const LAS v2u*)(vp + 16);
                            const bf16x8 vf = __builtin_bit_cast(bf16x8, (v4u){lo.x, lo.y, hh.x, hh.y});
                            if (db == 0) o0 = __builtin_amdgcn_mfma_f32_32x32x16_bf16(vf, pf, o0, 0, 0, 0); else o1 = __builtin_amdgcn_mfma_f32_32x32x16_bf16(vf, pf, o1, 0, 0, 0); } }
                }
                if (__any(carry > SB_LIVE)) { if (lane == 0) flag[it & 1] = 1u; } else active = false;
            }
        }
        bf16* op = P.O + qrow * D + hq * 64;
#pragma unroll
        for (int g = 0; g < 4; ++g) { v2u w0, w1; w0.x = cvtpk(o0[4 * g], o0[4 * g + 1]); w0.y = cvtpk(o0[4 * g + 2], o0[4 * g + 3]); w1.x = cvtpk(o1[4 * g], o1[4 * g + 1]); w1.y = cvtpk(o1[4 * g + 2], o1[4 * g + 3]);
            *(GAS v2u*)(op + 8 * g + 4 * hi) = w0; *(GAS v2u*)(op + 32 + 8 * g + 4 * hi) = w1; }
    }
    __syncthreads();
}

struct Args { const float* in[16]; float* out; unsigned char* ws; int ph_lo, ph_hi; };
__global__ void __launch_bounds__(NWAVES * 64, 2) yoco_fwd(Args args) {
    extern __shared__ __attribute__((aligned(16))) unsigned char lds[];
    Frame F;
    F.lds = (LAS unsigned char*)lds;
    F.MISC = (volatile LAS unsigned*)(F.lds + MISC_OFF);
    F.tid = threadIdx.x; F.lane = F.tid & 63; F.wave = __builtin_amdgcn_readfirstlane(F.tid >> 6);
    F.G = gridDim.x; { const int bx = blockIdx.x; F.vcu = (F.G % 8 == 0) ? (bx % 8) * (F.G / 8) + bx / 8 : bx; }
    unsigned char* ws = args.ws;
    F.ctl = (gu32*)(ws + WS_CTL);
    Ptrs P;
    P.x = args.in[0]; P.ffn_norm = args.in[1]; P.ffn_w_in = args.in[2]; P.ffn_w_out = args.in[3]; P.mix_norm = args.in[4]; P.a_w_in = args.in[5]; P.a_ln_g = args.in[6]; P.a_ln_b = args.in[7];
    P.a_w_s = args.in[8]; P.a_b_s = args.in[9]; P.a_w_out = args.in[10]; P.kv_norm = args.in[11]; P.w_kv = args.in[12]; P.b_w_q = args.in[13]; P.b_w_o = args.in[14]; P.final_norm = args.in[15];
    P.X = args.out;
    P.WIN = (bf16*)(ws + WS_WIN); P.WOUT = (bf16*)(ws + WS_WOUT); P.AIN = (bf16*)(ws + WS_AIN); P.AOUT = (bf16*)(ws + WS_AOUT); P.WQ = (bf16*)(ws + WS_WQ); P.WO = (bf16*)(ws + WS_WO);
    P.XB = (bf16*)(ws + WS_XB); P.H = (bf16*)(ws + WS_H); P.U = (bf16*)(ws + WS_H); P.UV = (bf16*)(ws + WS_UV); P.O = (bf16*)(ws + WS_H); P.VTs = (bf16*)(ws + WS_R2);
    P.Q = (bf16*)(ws + WS_R2); P.Kb = (bf16*)(ws + WS_R2 + 32 * MiB); P.VTa = (bf16*)(ws + WS_R2 + 40 * MiB);
    P.ssq = (float*)(ws + WS_CTL) + CW_SSQ; P.vsum = (float*)(ws + WS_CTL) + CW_VSUM; P.vsq = (float*)(ws + WS_CTL) + CW_VSQ;
    for (int u = F.tid; u < (LDS_BYTES - LDSCTL_OFF) / 4; u += NWAVES * 64) ((LAS unsigned*)(F.lds + LDSCTL_OFF))[u] = 0u;
    __syncthreads();
    XcdBarrier bar; bar.bar = (unsigned*)(F.ctl + CW_BAR); bar.x = 0; bar.st = nullptr;
#if !MK_PER_PHASE
    bar = xcd_barrier_post((unsigned*)(F.ctl + CW_BAR), F.MISC + 8);
#endif
    const int lo = args.ph_lo, hi = args.ph_hi;
#define IN(k) (lo <= (k) && (k) < hi)
#if MK_PER_PHASE
#define SEAM(k) do { } while (0)
#define SEAM_CG(k) do { } while (0)
#else
#define SEAM(k) do { if (IN(k) && IN((k) + 1)) xcd_barrier(bar); } while (0)
#define SEAM_CG(k) do { if (IN(k) && IN((k) + 1)) { asm volatile("s_waitcnt vmcnt(0)" ::: "memory"); __threadfence(); cg::this_grid().sync(); } } while (0)
#endif
    using pg8::Gemm; using pg8::StaticOrder;
    LAS unsigned char* ring = F.lds + RING_OFF;
    const int bid = (int)blockIdx.x;
#define WINp(mat) ((const pg8::bf16_t*)((const char*)P.WIN + (size_t)(mat) * WIN_STRIDE))
#define WOUTp(mat) ((const pg8::bf16_t*)((const char*)P.WOUT + (size_t)(mat) * WOUT_STRIDE))
#define FFN_IN(mat, nn, ssqi) do { Gemm g{(const pg8::bf16_t*)P.XB, WINp(mat), M, (nn), D}; StaticOrder S; S.init(M, (nn), F.G, bid); \
        pg8::EpiSwiglu E{(pg8::bf16_t*)P.H, P.ssq + (ssqi) * M, (pg8::bf16_t*)P.Kb, (pg8::bf16_t*)P.VTa, NIN_FFN / 256}; \
        pg8::gemm_phase<pg8::EpiSwiglu, StaticOrder, true, true>(ring, g, S, E); } while (0)
#define FFN_OUT(mat, F32, ssqo) do { Gemm g{(const pg8::bf16_t*)P.H, WOUTp(mat), M, D, DFF}; StaticOrder S; S.init(M, D, F.G, bid); \
        pg8::EpiResid<F32> E{P.x, (pg8::bf16_t*)P.XB, P.ssq + (ssqo) * M, 0.5f}; \
        pg8::gemm_phase<pg8::EpiResid<F32>, StaticOrder, true, true>(ring, g, S, E); } while (0)

    if (args.ph_hi > 1000) SEAM_CG(0);
    if (IN(0)) { p0_prologue(F, P); if (PROBE_PHASE == 0) p0_prologue(F, P); } SEAM(0);
    if (IN(1)) { FFN_IN(0, NIN_FFN, 0); if (PROBE_PHASE == 1) FFN_IN(0, NIN_FFN, 0); } SEAM(1);
    if (IN(2)) { FFN_OUT(0, true, 1);
        if (PROBE_PHASE == 2) { Gemm g{(const pg8::bf16_t*)P.H, WOUTp(0), M, D, DFF}; StaticOrder S; S.init(M, D, F.G, bid);
            pg8::EpiResid<true> E{P.x, (pg8::bf16_t*)(ws + WS_R2), (float*)(ws + WS_CTL) + 196608, 0.5f};
            pg8::gemm_phase<pg8::EpiResid<true>, StaticOrder, true, true>(ring, g, S, E); } } SEAM(2);
    if (IN(3)) {
        { Gemm g{(const pg8::bf16_t*)P.XB, (const pg8::bf16_t*)P.AIN, M, DA, D}; StaticOrder S; S.init(M, DA, F.G, bid);
          pg8::EpiRowScale<1> E{(pg8::bf16_t*)P.U, DA, P.ssq + 1 * M, 1.0f};
          pg8::gemm_phase<pg8::EpiRowScale<1>, StaticOrder, true, true>(ring, g, S, E); }
        { Gemm g{(const pg8::bf16_t*)P.AIN + (size_t)DA * D, (const pg8::bf16_t*)P.XB, DA, M, D}; StaticOrder S; S.init(DA, M, F.G, bid);
          pg8::EpiGeluVT E{(pg8::bf16_t*)P.VTs, P.ssq + 1 * M, P.vsum, P.vsq};
          pg8::gemm_phase<pg8::EpiGeluVT, StaticOrder, true, true>(ring, g, S, E); }
    } SEAM(3);
    if (IN(4)) { sgu_phase(F, P); if (PROBE_PHASE == 4) sgu_phase(F, P); } SEAM(4);
    if (IN(5)) { Gemm g{(const pg8::bf16_t*)P.UV, (const pg8::bf16_t*)P.AOUT, M, D, DA}; StaticOrder S; S.init(M, D, F.G, bid);
        pg8::EpiResid<false> E{P.x, (pg8::bf16_t*)P.XB, P.ssq + 2 * M, 1.0f};
        pg8::gemm_phase<pg8::EpiResid<false>, StaticOrder, true, true>(ring, g, S, E); } SEAM(5);
    if (IN(6)) { FFN_IN(1, NIN_FFN, 2); } SEAM(6);
    if (IN(7)) { FFN_OUT(1, false, 3); } SEAM(7);
    if (IN(8)) { FFN_IN(2, NIN_KV, 3); } SEAM(8);
    if (IN(9)) { FFN_OUT(2, false, 4); } SEAM(9);
    if (IN(10)) { Gemm g{(const pg8::bf16_t*)P.XB, (const pg8::bf16_t*)P.WQ, M, D, D}; StaticOrder S; S.init(M, D, F.G, bid);
        pg8::EpiRowScale<0> E{(pg8::bf16_t*)P.Q, D, P.ssq + 4 * M, 0.125f * 1.4426950409f};
        pg8::gemm_phase<pg8::EpiRowScale<0>, StaticOrder, true, true>(ring, g, S, E); } SEAM(10);
    if (IN(11)) { attn_phase(F, P); if (PROBE_PHASE == 11) attn_phase(F, P); } SEAM(11);
    if (IN(12)) { Gemm g{(const pg8::bf16_t*)P.O, (const pg8::bf16_t*)P.WO, M, D, D}; StaticOrder S; S.init(M, D, F.G, bid);
        pg8::EpiResid<false> E{P.x, (pg8::bf16_t*)P.XB, P.ssq + 5 * M, 1.0f};
        pg8::gemm_phase<pg8::EpiResid<false>, StaticOrder, true, true>(ring, g, S, E); } SEAM(12);
    if (IN(13)) { FFN_IN(3, NIN_FFN, 5); } SEAM(13);
    if (IN(14)) { FFN_OUT(3, false, 6); } SEAM(14);
    if (IN(15)) { final_norm_phase(F, P); }
#undef IN
}

extern "C" void kernel_launch(void* const* d_in, const int* in_sizes, int n_in, void* d_out, int out_size, void* d_ws, size_t ws_size, hipStream_t stream) {
    static int grid = 0;
    if (grid == 0) {
        if (n_in != 16 || in_sizes[0] != M * D || out_size != M * D || ws_size < WS_END) { fprintf(stderr, "kernel_launch: unexpected shapes / workspace (n_in %d, in0 %d, out %d, ws %zu); nothing launched\n", n_in, n_in > 0 ? in_sizes[0] : -1, out_size, ws_size); grid = -1; return; }
        int dev = 0, cus = 0, per_cu = 0;
        if (hipGetDevice(&dev) != hipSuccess || hipDeviceGetAttribute(&cus, hipDeviceAttributeMultiprocessorCount, dev) != hipSuccess) { grid = -1; return; }
        if (hipFuncSetAttribute((const void*)yoco_fwd, hipFuncAttributeMaxDynamicSharedMemorySize, LDS_BYTES) != hipSuccess) { fprintf(stderr, "kernel_launch: hipFuncSetAttribute failed\n"); grid = -1; return; }
        if (hipOccupancyMaxActiveBlocksPerMultiprocessor(&per_cu, (const void*)yoco_fwd, NWAVES * 64, LDS_BYTES) != hipSuccess || per_cu < 1) { fprintf(stderr, "kernel_launch: occupancy query says %d blocks per CU\n", per_cu); (void)hipGetLastError(); per_cu = 1; }
        grid = cus;
    }
    if (grid < 0) return;
    if (hipMemsetAsync((char*)d_ws + WS_CTL, 0, CTL_ZERO_BYTES, stream) != hipSuccess) { fprintf(stderr, "kernel_launch: hipMemsetAsync failed\n"); return; }
    Args a{};
    for (int i = 0; i < 16; ++i) a.in[i] = (const float*)d_in[i];
    a.out = (float*)d_out; a.ws = (unsigned char*)d_ws;
#if MK_PER_PHASE
    for (int ph = 0; ph < N_PHASES; ++ph) { a.ph_lo = ph; a.ph_hi = ph + 1; hipLaunchKernelGGL(yoco_fwd, dim3(grid), dim3(NWAVES * 64), LDS_BYTES, stream, a); }
#else
    a.ph_lo = 0; a.ph_hi = N_PHASES;
    void* kargs[] = {&a};
    const hipError_t e = hipLaunchCooperativeKernel((const void*)yoco_fwd, dim3(grid), dim3(NWAVES * 64), kargs, LDS_BYTES, stream);
    if (e != hipSuccess) fprintf(stderr, "kernel_launch: cooperative launch failed: %s (grid %d)\n", hipGetErrorString(e), grid);
#endif
}
```

```cpp
#include <hip/hip_runtime.h>
#include <hip/hip_cooperative_groups.h>
#include <cstdio>
#include <cstdint>
namespace cg = cooperative_groups;
namespace pg8 {
#define PG8_LAS __attribute__((address_space(3)))
typedef unsigned short bf16_t;
typedef short bf16x8 __attribute__((ext_vector_type(8)));
typedef float f32x4 __attribute__((ext_vector_type(4)));
typedef unsigned u32x4 __attribute__((ext_vector_type(4)));
constexpr int BM = 256, BK = 64, HALF = 128, HTB = HALF * BK * 2  , STAGE_BYTES = 8 * HTB, NXCD = 8, WGM = 8;

__host__ __device__ __forceinline__ int lds_byte(int r, int c) { const int st = (r >> 4) * 2 + (c >> 5), rr = r & 15, cc = c & 31, ob = rr * 64 + cc * 2; return st * 1024 + (ob ^ (((ob >> 9) & 1) << 5)); }
__host__ __device__ __forceinline__ void stage_rc(int b, int& R, int& C) { const int st = b / 1024, sb = b % 1024, swz = sb ^ (((sb >> 9) & 1) << 5); R = (st >> 1) * 16 + swz / 64; C = (st & 1) * 32 + (swz % 64) / 2; }
__host__ __device__ __forceinline__ int perm32(int rho) { const int n = rho >> 4, i = rho & 15; return 8 * (i >> 2) + 4 * n + (i & 3); }

struct Unit { int pm, pn; };
struct Gemm { const bf16_t* A; const bf16_t* Bt; int M, N, K; };

struct StaticOrder {
    int nM, nN, nwg, G, c;
    __host__ __device__ void init(int M, int N, int G_, int c_) { nM = M / BM; nN = N / BM; nwg = nM * nN; G = G_; c = c_; }
    __host__ __device__ bool next(int i, Unit& u) const {
        const long L = (long)i * G + c; if (L >= nwg) return false;
        int wgid = (int)L; { const int q = nwg / NXCD, r = nwg % NXCD, xcd = wgid % NXCD, off = wgid / NXCD; wgid = (xcd < r ? xcd * (q + 1) : r * (q + 1) + (xcd - r) * q) + off; }
        const int nig = WGM * nN, gid = wgid / nig, fm = gid * WGM, gsz = (nM - fm) < WGM ? (nM - fm) : WGM;
        u.pm = fm + ((wgid % nig) % gsz); u.pn = (wgid % nig) / gsz; return true;
    }
    __device__ __forceinline__ void a_ready(const Unit&) const {}
    __device__ __forceinline__ void done(const Unit&) const {}
};

__device__ __forceinline__ unsigned cvt_pk_bf16(float lo, float hi) { unsigned r; asm volatile("v_cvt_pk_bf16_f32 %0, %1, %2" : "=v"(r) : "v"(lo), "v"(hi)); return r; }
typedef float f32x2 __attribute__((ext_vector_type(2)));
constexpr int EM = 16384, ED = 1024, EFF = 2816, EDA = 2048, ESEQ = 4096;
constexpr float RMS_EPS = 1e-6f;
__device__ __forceinline__ float silu_mul(float g, float u) { return g * u * __builtin_amdgcn_rcpf(1.f + __builtin_amdgcn_exp2f(-1.4426950409f * g)); }
__device__ __forceinline__ float gelu_tanh(float x) { const float t = x * (2.3022081f + 0.10294324f * x * x); return x * __builtin_amdgcn_rcpf(1.f + __builtin_amdgcn_exp2f(-t)); }
__device__ __forceinline__ float rstd_of(const float* ssq, int row) { return __builtin_amdgcn_rsqf(ssq[row] * (1.0f / 1024.0f) + RMS_EPS); }
__device__ __forceinline__ unsigned short bf16_1(float v) { return (unsigned short)(cvt_pk_bf16(v, 0.f) & 0xffffu); }

struct EpiSwiglu {
    static constexpr bool PERM = true, AFTER_DRAIN = false;
    bf16_t* H; const float* ssq; bf16_t* Kb; bf16_t* VT; int nffn;
    __device__ __forceinline__ void operator()(const f32x4 (&acc)[2][2][4][2], const Unit& u, int wr, int wc, int fr, int fq) const {
        const int row0 = u.pm * BM + wr * 64 + fr;
        if (u.pn < nffn) {
            const int col0 = u.pn * 128 + wc * 32 + 8 * fq;
#pragma unroll
            for (int ai = 0; ai < 2; ++ai)
#pragma unroll
                for (int m = 0; m < 4; ++m) { const int row = row0 + ai * HALF + m * 16; const float rs = rstd_of(ssq, row);
                    const f32x4 g0 = acc[ai][0][m][0] * rs, g1 = acc[ai][0][m][1] * rs, u0 = acc[ai][1][m][0] * rs, u1 = acc[ai][1][m][1] * rs;
                    u32x4 w; w.x = cvt_pk_bf16(silu_mul(g0[0], u0[0]), silu_mul(g0[1], u0[1])); w.y = cvt_pk_bf16(silu_mul(g0[2], u0[2]), silu_mul(g0[3], u0[3]));
                    w.z = cvt_pk_bf16(silu_mul(g1[0], u1[0]), silu_mul(g1[1], u1[1])); w.w = cvt_pk_bf16(silu_mul(g1[2], u1[2]), silu_mul(g1[3], u1[3]));
                    *(u32x4*)(H + (size_t)row * EFF + col0) = w; }
        } else {
            const int isv = u.pn - nffn;
#pragma unroll
            for (int ai = 0; ai < 2; ++ai)
#pragma unroll
                for (int m = 0; m < 4; ++m) { const int row = row0 + ai * HALF + m * 16; const float rs = rstd_of(ssq, row);
#pragma unroll
                    for (int bj = 0; bj < 2; ++bj) { const int col = bj * HALF + wc * 32 + 8 * fq; const f32x4 v0 = acc[ai][bj][m][0] * rs, v1 = acc[ai][bj][m][1] * rs;
                        if (isv == 0) { u32x4 w; w.x = cvt_pk_bf16(v0[0], v0[1]); w.y = cvt_pk_bf16(v0[2], v0[3]); w.z = cvt_pk_bf16(v1[0], v1[1]); w.w = cvt_pk_bf16(v1[2], v1[3]);
                            *(u32x4*)(Kb + (size_t)row * 256 + col) = w; }
                        else { const int b = row >> 12, s = row & (ESEQ - 1), kvh = col >> 6, d0 = col & 63;
                            bf16_t* p = VT + ((size_t)((b * 4 + kvh) * 64 + d0)) * ESEQ + s;
#pragma unroll
                            for (int e = 0; e < 4; ++e) { p[(size_t)e * ESEQ] = bf16_1(v0[e]); p[(size_t)(e + 4) * ESEQ] = bf16_1(v1[e]); } } } }
        }
    }
};
__device__ __forceinline__ float bf_lo(unsigned w) { return __uint_as_float(w << 16); }
__device__ __forceinline__ float bf_hi(unsigned w) { return __uint_as_float(w & 0xffff0000u); }
template <bool SRC_F32> struct EpiResid {
    static constexpr bool PERM = true, AFTER_DRAIN = false;
    const float* src32; bf16_t* xb; float* ssq_out; float scale;
    __device__ __forceinline__ void operator()(const f32x4 (&acc)[2][2][4][2], const Unit& u, int wr, int wc, int fr, int fq) const {
        const int row0 = u.pm * BM + wr * 64 + fr, col0 = u.pn * BM + wc * 32 + 8 * fq;
#pragma unroll
        for (int ai = 0; ai < 2; ++ai)
#pragma unroll
            for (int m = 0; m < 4; ++m) { const int row = row0 + ai * HALF + m * 16; float ss = 0.f;
#pragma unroll
                for (int bj = 0; bj < 2; ++bj) { const size_t off = (size_t)row * ED + col0 + bj * HALF;
                    f32x4 a0, a1;
                    if (SRC_F32) { a0 = *(const f32x4*)(src32 + off); a1 = *(const f32x4*)(src32 + off + 4); }
                    else { const u32x4 r = *(const u32x4*)(xb + off); a0 = (f32x4){bf_lo(r.x), bf_hi(r.x), bf_lo(r.y), bf_hi(r.y)}; a1 = (f32x4){bf_lo(r.z), bf_hi(r.z), bf_lo(r.w), bf_hi(r.w)}; }
                    const f32x4 v0 = a0 + acc[ai][bj][m][0] * scale, v1 = a1 + acc[ai][bj][m][1] * scale;
                    ss += (v0[0] * v0[0] + v0[1] * v0[1]) + (v0[2] * v0[2] + v0[3] * v0[3]) + (v1[0] * v1[0] + v1[1] * v1[1]) + (v1[2] * v1[2] + v1[3] * v1[3]);
                    u32x4 w; w.x = cvt_pk_bf16(v0[0], v0[1]); w.y = cvt_pk_bf16(v0[2], v0[3]); w.z = cvt_pk_bf16(v1[0], v1[1]); w.w = cvt_pk_bf16(v1[2], v1[3]);
                    *(u32x4*)(xb + off) = w; }
                ss += __shfl_xor(ss, 16); ss += __shfl_xor(ss, 32);
                if (fq == 0) unsafeAtomicAdd(ssq_out + row, ss);
                if (m & 1) asm volatile("" ::: "memory"); }
    }
};
template <int ACT> struct EpiRowScale {
    static constexpr bool PERM = true, AFTER_DRAIN = false;
    bf16_t* O; int ldc; const float* ssq; float oscale;
    __device__ __forceinline__ void operator()(const f32x4 (&acc)[2][2][4][2], const Unit& u, int wr, int wc, int fr, int fq) const {
        const int row0 = u.pm * BM + wr * 64 + fr, col0 = u.pn * BM + wc * 32 + 8 * fq;
#pragma unroll
        for (int ai = 0; ai < 2; ++ai)
#pragma unroll
            for (int m = 0; m < 4; ++m) { const int row = row0 + ai * HALF + m * 16; const float rs = rstd_of(ssq, row);
#pragma unroll
                for (int bj = 0; bj < 2; ++bj) { f32x4 v0 = acc[ai][bj][m][0] * rs, v1 = acc[ai][bj][m][1] * rs;
                    if (ACT == 1) {
#pragma unroll
                        for (int e = 0; e < 4; ++e) { v0[e] = gelu_tanh(v0[e]); v1[e] = gelu_tanh(v1[e]); } }
                    v0 = v0 * oscale; v1 = v1 * oscale;
                    u32x4 w; w.x = cvt_pk_bf16(v0[0], v0[1]); w.y = cvt_pk_bf16(v0[2], v0[3]); w.z = cvt_pk_bf16(v1[0], v1[1]); w.w = cvt_pk_bf16(v1[2], v1[3]);
                    *(u32x4*)(O + (size_t)row * ldc + col0 + bj * HALF) = w; } }
    }
};
struct EpiGeluVT {
    static constexpr bool PERM = true, AFTER_DRAIN = false;
    bf16_t* VT; const float* ssq; float* vsum; float* vsq;
    __device__ __forceinline__ void operator()(const f32x4 (&acc)[2][2][4][2], const Unit& u, int wr, int wc, int fr, int fq) const {
        const int row0 = u.pm * BM + wr * 64 + fr, col0 = u.pn * BM + wc * 32 + 8 * fq;
#pragma unroll
        for (int bj = 0; bj < 2; ++bj) {
            float rs[8], cs[8], cq[8];
#pragma unroll
            for (int e = 0; e < 8; ++e) { rs[e] = rstd_of(ssq, col0 + bj * HALF + e); cs[e] = 0.f; cq[e] = 0.f; }
#pragma unroll
            for (int ai = 0; ai < 2; ++ai)
#pragma unroll
                for (int m = 0; m < 4; ++m) { const int row = row0 + ai * HALF + m * 16; float v[8];
#pragma unroll
                    for (int e = 0; e < 4; ++e) { v[e] = gelu_tanh(acc[ai][bj][m][0][e] * rs[e]); v[e + 4] = gelu_tanh(acc[ai][bj][m][1][e] * rs[e + 4]); }
#pragma unroll
                    for (int e = 0; e < 8; ++e) { cs[e] += v[e]; cq[e] += v[e] * v[e]; }
                    u32x4 w; w.x = cvt_pk_bf16(v[0], v[1]); w.y = cvt_pk_bf16(v[2], v[3]); w.z = cvt_pk_bf16(v[4], v[5]); w.w = cvt_pk_bf16(v[6], v[7]);
                    *(u32x4*)(VT + (size_t)row * EM + col0 + bj * HALF) = w; }
#pragma unroll
            for (int e = 0; e < 8; ++e) {
#pragma unroll
                for (int o = 1; o < 16; o <<= 1) { cs[e] += __shfl_xor(cs[e], o); cq[e] += __shfl_xor(cq[e], o); } }
            if (fr == 0) {
#pragma unroll
                for (int e = 0; e < 8; ++e) { unsafeAtomicAdd(vsum + col0 + bj * HALF + e, cs[e]); unsafeAtomicAdd(vsq + col0 + bj * HALF + e, cq[e]); } }
        }
    }
};

template <class Epi, class Sched, bool ALIGN_EPI = false, bool SP2 = false>
__device__ __forceinline__ void gemm_phase(PG8_LAS unsigned char* lds, const Gemm g, const Sched& S, const Epi& E) {
    const int tid = threadIdx.x, wid = __builtin_amdgcn_readfirstlane(tid >> 6), lane = tid & 63, wr = wid >> 2, wc = wid & 3, fr = lane & 15, fq = lane >> 4;
    const int K = g.K, nt = K / BK;
    unsigned voffA[2], voffB[2];
#pragma unroll
    for (int i = 0; i < 2; ++i) { int R, C; stage_rc(tid * 16 + i * 8192, R, C); const int Rb = Epi::PERM ? ((R & ~31) + perm32(R & 31)) : R;
        voffA[i] = (unsigned)(R * K + C) * 2u; voffB[i] = (unsigned)(Rb * K + C) * 2u; }
    const size_t kstep = (size_t)(BK * 2);
    const size_t hstep = (size_t)HALF * K * 2;
    const size_t tstep = 2 * hstep;
    const unsigned ldsw = (unsigned)wid * 1024u;
    const int aoff = lds_byte(wr * 64 + fr, fq * 8), boff = lds_byte(wc * 32 + fr, fq * 8);
#define PG8_SA(b, h) (((b) * 2 + (h)) * HTB)
#define PG8_SB(b, h) ((4 + (b) * 2 + (h)) * HTB)
#define PG8_STAGE(bufoff, gbase, voff) do { _Pragma("unroll") for (int _i = 0; _i < 2; ++_i) \
        __builtin_amdgcn_global_load_lds((const unsigned*)((const char*)(gbase) + (voff)[_i]), (PG8_LAS unsigned*)(lds + (bufoff) + ldsw + _i * 8192), 16, 0, 0); } while (0)
#define PG8_LDA(dst, b, h) do { _Pragma("unroll") for (int m = 0; m < 4; ++m) _Pragma("unroll") for (int k = 0; k < 2; ++k) dst[m][k] = *(const PG8_LAS bf16x8*)(lds + PG8_SA(b, h) + aoff + m * 2048 + k * 1024); } while (0)
#define PG8_LDB(dst, b, h) do { _Pragma("unroll") for (int n = 0; n < 2; ++n) _Pragma("unroll") for (int k = 0; k < 2; ++k) dst[n][k] = *(const PG8_LAS bf16x8*)(lds + PG8_SB(b, h) + boff + n * 2048 + k * 1024); } while (0)
#define PG8_MMA(ai, bj, At, Bt) do { __builtin_amdgcn_s_setprio(1); _Pragma("unroll") for (int m = 0; m < 4; ++m) _Pragma("unroll") for (int n = 0; n < 2; ++n) _Pragma("unroll") for (int k = 0; k < 2; ++k) \
        acc[ai][bj][m][n] = __builtin_amdgcn_mfma_f32_16x16x32_bf16(Bt[n][k], At[m][k], acc[ai][bj][m][n], 0, 0, 0); __builtin_amdgcn_s_setprio(0); } while (0)
#define PG8_WAIT_V(n) asm volatile("s_waitcnt vmcnt(" #n ")" ::: "memory")
#define PG8_WAIT_L(n) asm volatile("s_waitcnt lgkmcnt(" #n ")" ::: "memory")
#define PG8_BAR __builtin_amdgcn_s_barrier()
#define PG8_SCHED __builtin_amdgcn_sched_barrier(0)
    Unit cur, nxt; int ui = 0;
    if (!S.next(0, cur)) return;
    f32x4 acc[2][2][4][2];
#pragma unroll
    for (int a = 0; a < 2; ++a)
#pragma unroll
        for (int b = 0; b < 2; ++b)
#pragma unroll
            for (int m = 0; m < 4; ++m)
#pragma unroll
                for (int n = 0; n < 2; ++n) acc[a][b][m][n] = (f32x4){0.f, 0.f, 0.f, 0.f};
    bf16x8 At[4][2], B0[2][2], B1[2][2];
    const char* cA = (const char*)g.A + (size_t)cur.pm * tstep; const char* cB = (const char*)g.Bt + (size_t)cur.pn * tstep;
    S.a_ready(cur);
    if constexpr (SP2) {
        PG8_STAGE(PG8_SB(0, 0), cB, voffB); PG8_STAGE(PG8_SB(0, 1), cB + hstep, voffB); PG8_STAGE(PG8_SA(0, 0), cA, voffA); PG8_STAGE(PG8_SA(0, 1), cA + hstep, voffA);
        if (wr == 1) PG8_BAR;
        PG8_WAIT_V(2); PG8_BAR;
        PG8_STAGE(PG8_SB(1, 0), cB + kstep, voffB); PG8_STAGE(PG8_SA(1, 0), cA + kstep, voffA); PG8_STAGE(PG8_SB(1, 1), cB + hstep + kstep, voffB);
        PG8_WAIT_V(6); PG8_BAR;
    } else {
        PG8_STAGE(PG8_SB(0, 0), cB, voffB); PG8_STAGE(PG8_SA(0, 0), cA, voffA); PG8_STAGE(PG8_SB(0, 1), cB + hstep, voffB); PG8_STAGE(PG8_SA(0, 1), cA + hstep, voffA);
        if (wr == 1) PG8_BAR;
        PG8_WAIT_V(4); PG8_BAR;
        PG8_STAGE(PG8_SB(1, 0), cB + kstep, voffB); PG8_STAGE(PG8_SA(1, 0), cA + kstep, voffA); PG8_STAGE(PG8_SB(1, 1), cB + hstep + kstep, voffB);
        PG8_WAIT_V(6); PG8_BAR;
    }
    for (;;) {
        const bool has_next = S.next(ui + 1, nxt);
        const char* nA = has_next ? (const char*)g.A + (size_t)nxt.pm * tstep : cA; const char* nB = has_next ? (const char*)g.Bt + (size_t)nxt.pn * tstep : cB;
        for (int t = 0; t < nt; t += 2) {
            const bool last = (t == nt - 2);
            const char* a1 = cA + (size_t)(t + 1) * kstep;
            const char* a2 = last ? nA : cA + (size_t)(t + 2) * kstep; const char* b2 = last ? nB : cB + (size_t)(t + 2) * kstep;
            const char* a3 = a2 + kstep; const char* b3 = b2 + kstep;
            if (last && has_next) S.a_ready(nxt);
            if constexpr (SP2) {
            PG8_LDB(B0, 0, 0); PG8_LDB(B1, 0, 1); PG8_SCHED; PG8_LDA(At, 0, 0); PG8_STAGE(PG8_SA(1, 1), a1 + hstep, voffA);
            PG8_WAIT_V(8); PG8_WAIT_L(0); PG8_BAR; PG8_MMA(0, 0, At, B0); PG8_MMA(0, 1, At, B1); PG8_BAR; PG8_SCHED;
            PG8_LDA(At, 0, 1); PG8_STAGE(PG8_SB(0, 0), b2, voffB); PG8_STAGE(PG8_SB(0, 1), b2 + hstep, voffB); PG8_STAGE(PG8_SA(0, 0), a2, voffA);
            PG8_WAIT_V(8); PG8_WAIT_L(0); PG8_BAR; PG8_MMA(1, 0, At, B0); PG8_MMA(1, 1, At, B1); PG8_BAR; PG8_SCHED;
            PG8_LDB(B0, 1, 0); PG8_LDB(B1, 1, 1); PG8_SCHED; PG8_LDA(At, 1, 0); PG8_STAGE(PG8_SA(0, 1), a2 + hstep, voffA);
            PG8_WAIT_V(8); PG8_WAIT_L(0); PG8_BAR; PG8_MMA(0, 0, At, B0); PG8_MMA(0, 1, At, B1); PG8_BAR; PG8_SCHED;
            PG8_LDA(At, 1, 1); PG8_STAGE(PG8_SB(1, 0), b3, voffB); PG8_STAGE(PG8_SB(1, 1), b3 + hstep, voffB); PG8_STAGE(PG8_SA(1, 0), a3, voffA);
            PG8_WAIT_V(8); PG8_WAIT_L(0); PG8_BAR; PG8_MMA(1, 0, At, B0); PG8_MMA(1, 1, At, B1); PG8_BAR; PG8_SCHED;
            } else {
            PG8_LDB(B0, 0, 0); PG8_SCHED; PG8_LDA(At, 0, 0); PG8_STAGE(PG8_SA(1, 1), a1 + hstep, voffA);
            PG8_WAIT_L(8); PG8_BAR; PG8_WAIT_L(0); PG8_MMA(0, 0, At, B0); PG8_BAR; PG8_SCHED;
            PG8_LDB(B1, 0, 1); PG8_STAGE(PG8_SB(0, 0), b2, voffB);
            PG8_BAR; PG8_WAIT_L(0); PG8_MMA(0, 1, At, B1); PG8_BAR;
            PG8_LDA(At, 0, 1); PG8_STAGE(PG8_SA(0, 0), a2, voffA);
            PG8_BAR; PG8_WAIT_L(0); PG8_MMA(1, 0, At, B0); PG8_BAR; PG8_SCHED;
            PG8_STAGE(PG8_SB(0, 1), b2 + hstep, voffB);
            PG8_WAIT_V(6); PG8_BAR; PG8_MMA(1, 1, At, B1); PG8_BAR;
            PG8_LDB(B0, 1, 0); PG8_SCHED; PG8_LDA(At, 1, 0); PG8_STAGE(PG8_SA(0, 1), a2 + hstep, voffA);
            PG8_WAIT_L(8); PG8_BAR; PG8_WAIT_L(0); PG8_MMA(0, 0, At, B0); PG8_BAR; PG8_SCHED;
            PG8_LDB(B1, 1, 1); PG8_STAGE(PG8_SB(1, 0), b3, voffB);
            PG8_BAR; PG8_WAIT_L(0); PG8_MMA(0, 1, At, B1); PG8_BAR;
            PG8_LDA(At, 1, 1); PG8_STAGE(PG8_SA(1, 0), a3, voffA);
            PG8_BAR; PG8_WAIT_L(0); PG8_MMA(1, 0, At, B0); PG8_BAR; PG8_SCHED;
            PG8_STAGE(PG8_SB(1, 1), b3 + hstep, voffB);
            PG8_WAIT_V(6); PG8_BAR; PG8_MMA(1, 1, At, B1); PG8_BAR;
            }
        }
        if constexpr (ALIGN_EPI) { if (wr == 0) PG8_BAR; }
        if constexpr (!Epi::AFTER_DRAIN) { E(acc, cur, wr, wc, fr, fq); S.done(cur); }
        if (!has_next) break;
#pragma unroll
        for (int a = 0; a < 2; ++a)
#pragma unroll
            for (int b = 0; b < 2; ++b)
#pragma unroll
                for (int m = 0; m < 4; ++m)
#pragma unroll
                    for (int n = 0; n < 2; ++n) acc[a][b][m][n] = (f32x4){0.f, 0.f, 0.f, 0.f};
        cur = nxt; cA = nA; cB = nB; ++ui;
        if constexpr (ALIGN_EPI) { if (wr == 1) PG8_BAR; }
    }
    PG8_WAIT_V(0);
    if constexpr (!ALIGN_EPI) { if (wr == 0) PG8_BAR; }
    PG8_BAR;
    if constexpr (Epi::AFTER_DRAIN) { E.fused(acc, cur, wr, wc, fr, fq, lds, wid, lane); S.done(cur); }
#undef PG8_SA
#undef PG8_SB
#undef PG8_STAGE
#undef PG8_LDA
#undef PG8_LDB
#undef PG8_MMA
#undef PG8_WAIT_V
#undef PG8_WAIT_L
#undef PG8_BAR
#undef PG8_SCHED
}
}
constexpr int NWAVES = 8;
constexpr int M = 16384, D = 1024, DFF = 2816, DA = 2048, SEQ = 4096, NBATCH = 4;
constexpr int NIN_FFN = 2 * DFF;
constexpr int NIN_KV = NIN_FFN + 512;
#ifndef MK_PER_PHASE
#define MK_PER_PHASE 0
#endif
constexpr int N_PHASES = 16;
#ifndef PROBE_PHASE
#define PROBE_PHASE -1
#endif

constexpr size_t MiB = 1u << 20;
constexpr size_t WS_CTL = 0, CTL_ZERO_BYTES = 1 * MiB;
constexpr size_t WS_WIN = 2 * MiB;
constexpr size_t WIN_STRIDE = 12 * MiB;
constexpr size_t WS_WOUT = WS_WIN + 4 * WIN_STRIDE;
constexpr size_t WOUT_STRIDE = 6 * MiB;
constexpr size_t WS_AIN = WS_WOUT + 4 * WOUT_STRIDE;
constexpr size_t WS_AOUT = WS_AIN + 8 * MiB;
constexpr size_t WS_WQ = WS_AOUT + 4 * MiB;
constexpr size_t WS_WO = WS_WQ + 2 * MiB;
constexpr size_t WS_XB = WS_WO + 2 * MiB;
constexpr size_t WS_H = WS_XB + 32 * MiB;
constexpr size_t WS_R2 = WS_H + 88 * MiB;
constexpr size_t WS_UV = WS_R2 + 64 * MiB;
constexpr size_t WS_END = WS_UV + 64 * MiB;
constexpr int CW_BAR = 4096;
constexpr int CW_SSQ = 16384;
constexpr int CW_VSUM = CW_SSQ + 7 * M, CW_VSQ = CW_VSUM + M;
static_assert((size_t)(CW_VSQ + M) * 4 <= CTL_ZERO_BYTES, "CTL words inside the memset region");

constexpr int RING_OFF = 0, RING_BYTES = 131072;
constexpr int LDSCTL_OFF = RING_BYTES, MISC_OFF = LDSCTL_OFF + 320;
constexpr int LDS_BYTES = 147456;

#define GAS __attribute__((address_space(1)))
#define LAS __attribute__((address_space(3)))
typedef unsigned short bf16;
typedef unsigned v4u __attribute__((ext_vector_type(4)));
typedef float f32x4 __attribute__((ext_vector_type(4)));
typedef short bf16x8 __attribute__((ext_vector_type(8)));
typedef GAS unsigned gu32;
typedef GAS unsigned long long gu64;
#define RLX_AGENT __ATOMIC_RELAXED, __HIP_MEMORY_SCOPE_AGENT
#define LDS_WAIT() asm volatile("s_waitcnt lgkmcnt(0)" ::: "memory")
#define VM_WAIT() asm volatile("s_waitcnt vmcnt(0)" ::: "memory")
__device__ __forceinline__ unsigned long long rt() { return __builtin_amdgcn_s_memrealtime(); }
__device__ __forceinline__ unsigned f2bf(float f) { unsigned u = __builtin_bit_cast(unsigned, f); return (u + 0x7fffu + ((u >> 16) & 1u)) >> 16; }
__device__ __forceinline__ unsigned pk2(float lo, float hi) { return f2bf(lo) | (f2bf(hi) << 16); }

#define XB_TMO      128
#define XB_XCNT(j)  (256  + 64 * (j))
#define XB_XSUB(j)  (1280 + 64 * (j))
#define XB_XGEN(j)  (2304 + 64 * (j))
#define XB_TOP      3328
#define XB_TOPGEN   3392
#define XCD_BAR_WORDS 3456
#define XB_SPIN_CAP (1u << 18)

__device__ __forceinline__ unsigned xb_ld(unsigned* p)              { return __hip_atomic_load(p, __ATOMIC_RELAXED, __HIP_MEMORY_SCOPE_AGENT); }
__device__ __forceinline__ unsigned xb_add(unsigned* p, unsigned v) { return __hip_atomic_fetch_add(p, v, __ATOMIC_RELAXED, __HIP_MEMORY_SCOPE_AGENT); }
__device__ __forceinline__ unsigned xb_xcc_id() { return (unsigned)__builtin_amdgcn_s_getreg((3 << 11) | 20) & 0xFu; }
#define XB_SPIN(cond, bar) do { unsigned _sp = 0; while (cond) { __builtin_amdgcn_s_sleep(1); \
    if ((++_sp & 255u) == 0u) { if (xb_ld(&(bar)[XB_TMO])) break; if (_sp > XB_SPIN_CAP) { atomicAdd(&(bar)[XB_TMO], 1u); break; } } } } while (0)

struct XcdBarrier {
    unsigned* bar; unsigned x;
    volatile LAS unsigned* st;
};

__device__ __forceinline__ XcdBarrier xcd_barrier_post(unsigned* bar, volatile LAS unsigned* st) {
    XcdBarrier b; b.bar = bar; b.x = xb_xcc_id(); b.st = st;
    if (threadIdx.x == 0) (void)xb_add(&bar[XB_XCNT(b.x)], 1u);
    return b;
}
__device__ __forceinline__ void xcd_barrier_complete(unsigned* bar, unsigned x, unsigned& nloc, unsigned& nx) {
    const unsigned G = gridDim.x * gridDim.y * gridDim.z;
    unsigned sum, cnt, mine, sp = 0u;
    for (;;) {
        sum = 0u; cnt = 0u; mine = 0u;
#pragma unroll
        for (unsigned j = 0; j < 16; ++j) { const unsigned c = xb_ld(&bar[XB_XCNT(j)]); sum += c; cnt += (c > 0u) ? 1u : 0u; mine = (j == x) ? c : mine; }
        if (sum == G) break;
        __builtin_amdgcn_s_sleep(1);
        if ((++sp & 255u) == 0u) { if (xb_ld(&bar[XB_TMO])) break; if (sp > XB_SPIN_CAP) { atomicAdd(&bar[XB_TMO], 1u); break; } }
    }
    nloc = mine > 0u ? mine : 1u; nx = cnt > 0u ? cnt : 1u;
}

__device__ __forceinline__ void xcd_barrier(const XcdBarrier& b) {
    asm volatile("s_waitcnt vmcnt(0)" ::: "memory");
    __syncthreads();
    if (threadIdx.x == 0) {
        unsigned* bar = b.bar;
        __builtin_amdgcn_s_waitcnt(0);
        unsigned nloc = b.st[0], nx = b.st[1];
        if (nloc == 0u) { xcd_barrier_complete(bar, b.x, nloc, nx); b.st[0] = nloc; b.st[1] = nx; }
        const unsigned old = xb_add(&bar[XB_XSUB(b.x)], 1u);
        const unsigned gen = old / nloc;
        if (old + 1u == (gen + 1u) * nloc) {
            __builtin_amdgcn_fence(__ATOMIC_RELEASE, "agent");
            asm volatile("s_waitcnt vmcnt(0)" ::: "memory");
            const unsigned og = xb_add(&bar[XB_TOP], 1u);
            const unsigned tg = og / nx;
            if (og + 1u == (tg + 1u) * nx) xb_add(&bar[XB_TOPGEN], 1u);
            else XB_SPIN(xb_ld(&bar[XB_TOPGEN]) == tg, bar);
            __builtin_amdgcn_fence(__ATOMIC_ACQUIRE, "agent");
            xb_add(&bar[XB_XGEN(b.x)], 1u);
            asm volatile("s_waitcnt vmcnt(0)" ::: "memory");
        } else {
            XB_SPIN(xb_ld(&bar[XB_XGEN(b.x)]) == gen, bar);
            __builtin_amdgcn_fence(__ATOMIC_ACQUIRE, "agent");
            asm volatile("s_waitcnt vmcnt(0)" ::: "memory");
        }
    }
    __syncthreads();
}
typedef float f32x16 __attribute__((ext_vector_type(16)));
typedef short s16x4 __attribute__((ext_vector_type(4)));
typedef unsigned v2u __attribute__((ext_vector_type(2)));
typedef float f32x2_t __attribute__((ext_vector_type(2))); typedef __bf16 bf16x2_t __attribute__((ext_vector_type(2)));
__device__ __forceinline__ unsigned cvtpk(float lo, float hi) { f32x2_t v = {lo, hi}; bf16x2_t b = __builtin_convertvector(v, bf16x2_t); return __builtin_bit_cast(unsigned, b); }
__device__ __forceinline__ float bflo(unsigned w) { return __uint_as_float(w << 16); }
__device__ __forceinline__ float bfhi(unsigned w) { return __uint_as_float(w & 0xffff0000u); }

struct Frame {
    LAS unsigned char* lds;
    volatile LAS unsigned* MISC;
    gu32* ctl;
    int tid, lane, wave;
    int vcu, G;
};
__device__ __forceinline__ float wave_sum(float v) {
#pragma unroll
    for (int o = 1; o < 64; o <<= 1) v += __shfl_xor(v, o);
    return v;
}
__device__ __forceinline__ void p0_item(const float* W, int ldn, int K, int nblk, bf16* WT, const float* gk, int mode, LAS float* scr, int item, int lane) {
    const int kb = item / nblk, nb = item % nblk, k0 = 64 * kb, n0 = 32 * nb;
    const int rowb = (mode == 0) ? n0 : (256 * (n0 >> 7) + (n0 & 127) + (mode == 2 ? 128 : 0));
    const int kr = lane >> 3, n4 = (lane & 7) * 4;
    f32x4 w[8];
#pragma unroll
    for (int i = 0; i < 8; ++i) w[i] = *(const GAS f32x4*)(W + (size_t)(k0 + i * 8 + kr) * ldn + n0 + n4);
    if (gk) {
#pragma unroll
        for (int i = 0; i < 8; ++i) w[i] = w[i] * gk[k0 + i * 8 + kr]; }
#pragma unroll
    for (int i = 0; i < 8; ++i) { LAS float* d = scr + (i * 8 + kr) * 33 + n4; d[0] = w[i].x; d[1] = w[i].y; d[2] = w[i].z; d[3] = w[i].w; }
    LDS_WAIT(); asm volatile("" ::: "memory");
    const int c = lane & 7;
#pragma unroll
    for (int j = 0; j < 4; ++j) { const int n = (lane >> 3) + 8 * j; const LAS float* s = scr + (8 * c) * 33 + n;
        v4u o; o.x = pk2(s[0 * 33], s[1 * 33]); o.y = pk2(s[2 * 33], s[3 * 33]); o.z = pk2(s[4 * 33], s[5 * 33]); o.w = pk2(s[6 * 33], s[7 * 33]);
        *(GAS v4u*)(WT + (size_t)(rowb + n) * K + k0 + 8 * c) = o; }
    LDS_WAIT(); asm volatile("" ::: "memory");
}
struct Ptrs {
    const float *x, *ffn_norm, *ffn_w_in, *ffn_w_out, *mix_norm, *a_w_in, *a_ln_g, *a_ln_b, *a_w_s, *a_b_s, *a_w_out, *kv_norm, *w_kv, *b_w_q, *b_w_o, *final_norm;
    float* X;
    bf16 *WIN, *WOUT, *AIN, *AOUT, *WQ, *WO, *XB, *H, *U, *UV, *O, *VTs, *Q, *Kb, *VTa;
    float *ssq, *vsum, *vsq;
};
constexpr int I_IN = 16 * (DFF / 32);
constexpr int I_KV = 16 * (512 / 32);
constexpr int I_OUT = (DFF / 64) * (D / 32);
constexpr int I_AIN = 16 * (2 * DA / 32);
constexpr int I_AOUT = (DA / 64) * (D / 32);
constexpr int I_Q = 16 * 32;
constexpr int IT_KV = 8 * I_IN, IT_OUT = IT_KV + I_KV, IT_AIN = IT_OUT + 4 * I_OUT, IT_AOUT = IT_AIN + I_AIN, IT_Q = IT_AOUT + I_AOUT, IT_O = IT_Q + I_Q, NITEMS = IT_O + I_Q;
__device__ __forceinline__ void convert_one(const Ptrs& P, LAS float* scr, int it, int lane) {
    int r = it;
    if (r < 8 * I_IN) { const int mat = r / (2 * I_IN), rr = r % (2 * I_IN), up = rr / I_IN, item = rr % I_IN;
        p0_item(P.ffn_w_in + (size_t)mat * D * NIN_FFN + up * DFF, NIN_FFN, D, DFF / 32, (bf16*)((char*)P.WIN + mat * WIN_STRIDE), P.ffn_norm + mat * D, 1 + up, scr, item, lane); return; }
    r -= 8 * I_IN;
    if (r < I_KV) { p0_item(P.w_kv, 512, D, 16, (bf16*)((char*)P.WIN + 2 * WIN_STRIDE) + (size_t)NIN_FFN * D, P.kv_norm, 0, scr, r, lane); return; }
    r -= I_KV;
    if (r < 4 * I_OUT) { const int mat = r / I_OUT, item = r % I_OUT;
        p0_item(P.ffn_w_out + (size_t)mat * DFF * D, D, DFF, D / 32, (bf16*)((char*)P.WOUT + mat * WOUT_STRIDE), nullptr, 0, scr, item, lane); return; }
    r -= 4 * I_OUT;
    if (r < I_AIN) { p0_item(P.a_w_in, 2 * DA, D, 2 * DA / 32, P.AIN, P.mix_norm, 0, scr, r, lane); return; }
    r -= I_AIN;
    if (r < I_AOUT) { p0_item(P.a_w_out, D, DA, D / 32, P.AOUT, nullptr, 0, scr, r, lane); return; }
    r -= I_AOUT;
    if (r < I_Q) { p0_item(P.b_w_q, D, D, D / 32, P.WQ, P.mix_norm + D, 0, scr, r, lane); return; }
    r -= I_Q;
    p0_item(P.b_w_o, D, D, D / 32, P.WO, nullptr, 0, scr, r, lane);
}
__device__ __forceinline__ void convert_batch(Frame& F, const Ptrs& P, int batch, int nunits) {
    const int G = F.G, bid = (int)blockIdx.x, rounds = (nunits + G - 1) / G, first_short = nunits - (rounds - 1) * G;
    int nshort = G - first_short, sidx = bid - first_short;
    if (nshort == 0) { nshort = G; sidx = bid; }
    if (sidx < 0) return;
    LAS float* scr = (LAS float*)(F.lds + RING_OFF + F.wave * 16384);
    const int n = batch == 1 ? (2 * I_IN + 2 * I_OUT + I_AIN + I_AOUT) : (4 * I_IN + I_KV + 2 * I_OUT + 2 * I_Q);
    for (int j = sidx * NWAVES + F.wave; j < n; j += nshort * NWAVES) {
        int it;
        if (batch == 1) it = j < 2 * I_IN ? 2 * I_IN + j : (j < 2 * I_IN + 2 * I_OUT ? IT_OUT + (j - 2 * I_IN) : IT_AIN + (j - 2 * I_IN - 2 * I_OUT));
        else it = j < 4 * I_IN + I_KV ? 4 * I_IN + j : (j < 4 * I_IN + I_KV + 2 * I_OUT ? IT_OUT + 2 * I_OUT + (j - 4 * I_IN - I_KV) : IT_Q + (j - 4 * I_IN - I_KV - 2 * I_OUT));
        convert_one(P, scr, it, F.lane);
    }
}
__device__ __forceinline__ void p0_prologue(Frame& F, const Ptrs& P) {
    LAS float* scr = (LAS float*)(F.lds + RING_OFF + F.wave * 16384);
    const int gw = F.vcu * NWAVES + F.wave, NGW = F.G * NWAVES;
    for (int it = gw; it < 2 * I_IN; it += NGW) convert_one(P, scr, it, F.lane);
    for (int m = gw; m < M; m += NGW) {
        const GAS f32x4* xr = (const GAS f32x4*)(P.x + (size_t)m * D) + F.lane;
        f32x4 v[4]; float s = 0.f;
#pragma unroll
        for (int j = 0; j < 4; ++j) { v[j] = xr[64 * j]; s += (v[j].x * v[j].x + v[j].y * v[j].y) + (v[j].z * v[j].z + v[j].w * v[j].w); }
        s = wave_sum(s);
        GAS unsigned long long* o8 = (GAS unsigned long long*)(P.XB + (size_t)m * D) + F.lane;
#pragma unroll
        for (int j = 0; j < 4; ++j) o8[64 * j] = (unsigned long long)pk2(v[j].x, v[j].y) | ((unsigned long long)pk2(v[j].z, v[j].w) << 32);
        if (F.lane == 0) P.ssq[m] = s;
    }
}
__device__ __forceinline__ void final_norm_phase(Frame& F, const Ptrs& P) {
    const int gw = F.vcu * NWAVES + F.wave, NGW = F.G * NWAVES;
    f32x4 g0[2], g1[2];
#pragma unroll
    for (int j = 0; j < 2; ++j) { g0[j] = ((const GAS f32x4*)P.final_norm)[2 * F.lane + 128 * j]; g1[j] = ((const GAS f32x4*)P.final_norm)[2 * F.lane + 128 * j + 1]; }
    for (int m = gw; m < M; m += NGW) {
        const float rs = __builtin_amdgcn_rsqf(P.ssq[6 * M + m] * (1.0f / 1024.0f) + 1e-6f);
#pragma unroll
        for (int j = 0; j < 2; ++j) { const v4u r = ((const GAS v4u*)(P.XB + (size_t)m * D))[F.lane + 64 * j];
            GAS f32x4* o = (GAS f32x4*)(P.X + (size_t)m * D) + 2 * F.lane + 128 * j;
            o[0] = (f32x4){bflo(r.x), bfhi(r.x), bflo(r.y), bfhi(r.y)} * rs * g0[j]; o[1] = (f32x4){bflo(r.z), bfhi(r.z), bflo(r.w), bfhi(r.w)} * rs * g1[j]; }
    }
}

constexpr int SG_WM = 0, SG_LD = 272, SG_BT = 128 * SG_LD  , SG_CLD = 528, SG_STAT = SG_BT + 256 * SG_LD  ;
static_assert(128 * SG_CLD <= 256 * SG_LD && SG_STAT + 1024 <= RING_BYTES, "sgu LDS map");
__device__ __forceinline__ void sgu_phase(Frame& F, const Ptrs& P) {
    LAS unsigned char* lds = F.lds + RING_OFF;
    const int tid = F.tid, lane = F.lane, wid = F.wave, fr = lane & 15, fq = lane >> 4, wt = wid >> 2, wc = wid & 3;
    const int s8 = (tid & 15) * 8, crow0 = tid >> 4;
    int gload = -1;
    v4u vraw[8]; float st_sum = 0.f, st_sq = 0.f;
#define SG_PREFETCH(unx) do { const int g_ = (unx) & 7, tok_ = ((unx) >> 3) * 128; \
        _Pragma("unroll") for (int i = 0; i < 8; ++i) vraw[i] = *(const GAS v4u*)(P.VTs + (size_t)(g_ * 256 + i * 32 + crow0) * M + tok_ + s8); \
        if (tid < 128) { st_sum = P.vsum[tok_ + tid]; st_sq = P.vsq[tok_ + tid]; } } while (0)
    if (F.vcu < 1024) SG_PREFETCH(F.vcu);
    for (int un = F.vcu; un < 1024; un += F.G) {
        const int g = un & 7, chunk = un >> 3, tok0 = chunk * 128;
        __syncthreads();
        if (g != gload) {
            const float* ws = P.a_w_s + (size_t)g * 128 * 128;
#pragma unroll
            for (int i = 0; i < 4; ++i) { const int idx = i * 512 + tid, t = idx >> 4, sb = (idx & 15) * 8;
                const f32x4 a = *(const GAS f32x4*)(ws + t * 128 + sb), b = *(const GAS f32x4*)(ws + t * 128 + sb + 4);
                float v[8] = {a.x, a.y, a.z, a.w, b.x, b.y, b.z, b.w};
#pragma unroll
                for (int e = 0; e < 8; ++e) v[e] = (sb + e <= t) ? v[e] : 0.f;
                v4u o; o.x = cvtpk(v[0], v[1]); o.y = cvtpk(v[2], v[3]); o.z = cvtpk(v[4], v[5]); o.w = cvtpk(v[6], v[7]);
                *(LAS v4u*)(lds + SG_WM + t * SG_LD + sb * 2) = o; }
            gload = g;
        }
        if (tid < 128) { const float mean = st_sum * (1.0f / 2048.0f); const float var = fmaxf(st_sq * (1.0f / 2048.0f) - mean * mean, 0.f);
            ((LAS float*)(lds + SG_STAT))[tid] = mean; ((LAS float*)(lds + SG_STAT))[128 + tid] = __builtin_amdgcn_rsqf(var + 1e-5f); }
        __syncthreads();
        {
            float mu[8], rsd[8];
#pragma unroll
            for (int e = 0; e < 8; ++e) { mu[e] = ((LAS float*)(lds + SG_STAT))[s8 + e]; rsd[e] = ((LAS float*)(lds + SG_STAT))[128 + s8 + e]; }
#pragma unroll
            for (int i = 0; i < 8; ++i) { const int c = i * 32 + crow0, cgl = g * 256 + c;
                const v4u w = vraw[i]; const float lg = P.a_ln_g[cgl], lb = P.a_ln_b[cgl];
                float v[8] = {bflo(w.x), bfhi(w.x), bflo(w.y), bfhi(w.y), bflo(w.z), bfhi(w.z), bflo(w.w), bfhi(w.w)};
#pragma unroll
                for (int e = 0; e < 8; ++e) v[e] = (v[e] - mu[e]) * rsd[e] * lg + lb;
                v4u o; o.x = cvtpk(v[0], v[1]); o.y = cvtpk(v[2], v[3]); o.z = cvtpk(v[4], v[5]); o.w = cvtpk(v[6], v[7]);
                *(LAS v4u*)(lds + SG_BT + c * SG_LD + s8 * 2) = o; }
        }
        __syncthreads();
        v4u ureg[8];
#pragma unroll
        for (int i = 0; i < 8; ++i) { const int idx = i * 512 + tid, t = idx >> 5, c8 = (idx & 31) * 8; ureg[i] = *(const GAS v4u*)(P.U + (size_t)(tok0 + t) * DA + g * 256 + c8); }
        if (un + F.G < 1024) SG_PREFETCH(un + F.G);
        f32x4 acc[4][4];
#pragma unroll
        for (int a = 0; a < 4; ++a)
#pragma unroll
            for (int b = 0; b < 4; ++b) acc[a][b] = (f32x4){0.f, 0.f, 0.f, 0.f};
#pragma unroll
        for (int ks = 0; ks < 4; ++ks) { bf16x8 af[4], bfr[4];
#pragma unroll
            for (int i = 0; i < 4; ++i) { af[i] = *(const LAS bf16x8*)(lds + SG_WM + (wt * 64 + i * 16 + fr) * SG_LD + (ks * 32 + fq * 8) * 2);
                                          bfr[i] = *(const LAS bf16x8*)(lds + SG_BT + (wc * 64 + i * 16 + fr) * SG_LD + (ks * 32 + fq * 8) * 2); }
#pragma unroll
            for (int mt = 0; mt < 4; ++mt)
#pragma unroll
                for (int nt = 0; nt < 4; ++nt) acc[mt][nt] = __builtin_amdgcn_mfma_f32_16x16x32_bf16(bfr[nt], af[mt], acc[mt][nt], 0, 0, 0); }
        __syncthreads();
#pragma unroll
        for (int mt = 0; mt < 4; ++mt) { const int t = wt * 64 + mt * 16 + fr; const float bs = P.a_b_s[g * 128 + t];
#pragma unroll
            for (int nt = 0; nt < 4; ++nt) { const int c = wc * 64 + nt * 16 + 4 * fq; const f32x4 v = acc[mt][nt] + bs;
                v2u o; o.x = cvtpk(v[0], v[1]); o.y = cvtpk(v[2], v[3]); *(LAS v2u*)(lds + SG_BT + t * SG_CLD + c * 2) = o; } }
        __syncthreads();
#pragma unroll
        for (int i = 0; i < 8; ++i) { const int idx = i * 512 + tid, t = idx >> 5, c8 = (idx & 31) * 8;
            const v4u cw = *(const LAS v4u*)(lds + SG_BT + t * SG_CLD + c8 * 2); const v4u uw = ureg[i];
            v4u o; o.x = cvtpk(bflo(cw.x) * bflo(uw.x), bfhi(cw.x) * bfhi(uw.x)); o.y = cvtpk(bflo(cw.y) * bflo(uw.y), bfhi(cw.y) * bfhi(uw.y));
            o.z = cvtpk(bflo(cw.z) * bflo(uw.z), bfhi(cw.z) * bfhi(uw.z)); o.w = cvtpk(bflo(cw.w) * bflo(uw.w), bfhi(cw.w) * bfhi(uw.w));
            *(GAS v4u*)(P.UV + (size_t)(tok0 + t) * DA + g * 256 + c8) = o; }
    }
#undef SG_PREFETCH
    __syncthreads();
}

constexpr int AT_K = 0, AT_KLD = 144, AT_V = 64 * AT_KLD  , AT_VLD = 136, AT_FLAG = AT_V + 64 * AT_VLD  ;
constexpr float SB_LIVE = 1.0e-43f;
__device__ __forceinline__ int crow(int r, int hi) { return (r & 3) + 8 * (r >> 2) + 4 * hi; }
template <bool MASKED> __device__ __forceinline__ void sb_block(f32x16& p, float& carry, int hi, int qloc, unsigned (&pk)[8]) {
    float om[16];
#pragma unroll
    for (int i = 0; i < 16; ++i) { om[i] = __builtin_amdgcn_rcpf(1.f + __builtin_amdgcn_exp2f(p[i])); if (MASKED) { if (!(crow(i, hi) < qloc)) om[i] = 1.f; } }
    float gp[4], pg[4];
#pragma unroll
    for (int g = 0; g < 4; ++g) gp[g] = (om[4 * g] * om[4 * g + 1]) * (om[4 * g + 2] * om[4 * g + 3]);
#pragma unroll
    for (int g = 0; g < 4; ++g) pg[g] = __shfl_xor(gp[g], 32);
    const float t0 = gp[0] * pg[0], t1 = gp[1] * pg[1], t2 = gp[2] * pg[2], t3 = gp[3] * pg[3];
    float above[4]; above[3] = 1.f; above[2] = t3; above[1] = t3 * t2; above[0] = above[1] * t1;
    const float total = above[0] * t0;
#pragma unroll
    for (int g = 0; g < 4; ++g) { float c = carry * above[g] * (hi == 0 ? pg[g] : 1.f);
#pragma unroll
        for (int e = 3; e >= 0; --e) { const int i = 4 * g + e; p[i] = (1.f - om[i]) * c; c *= om[i]; } }
    carry *= total;
#pragma unroll
    for (int j = 0; j < 8; ++j) pk[j] = cvtpk(p[2 * j], p[2 * j + 1]);
}
__device__ __forceinline__ void attn_phase(Frame& F, const Ptrs& P) {
    LAS unsigned char* lds = F.lds + RING_OFF;
    volatile LAS unsigned* flag = (volatile LAS unsigned*)(lds + AT_FLAG);
    const int tid = F.tid, lane = F.lane, wid = F.wave, r32 = lane & 31, hi = lane >> 5, half = wid & 1;
    const int lr = tid >> 3, lc8 = (tid & 7) * 8;
    for (int un = F.vcu; un < 1024; un += F.G) {
        const int bk = un & 15, qb = un >> 4, b = bk >> 2, kvh = bk & 3, hq = kvh * 4 + (wid >> 1);
        const size_t qrow = (size_t)b * SEQ + qb * 64 + half * 32 + r32;
        const bf16* kbase = P.Kb + ((size_t)b * SEQ + lr) * 256 + kvh * 64 + lc8;
        const bf16* vbase = P.VTa + ((size_t)(bk * 64 + lr)) * SEQ + lc8;
        v4u kw = *(const GAS v4u*)(kbase + (size_t)qb * 64 * 256), vw = *(const GAS v4u*)(vbase + qb * 64);
        bf16x8 qr[4];
#pragma unroll
        for (int d0 = 0; d0 < 4; ++d0) qr[d0] = *(const GAS bf16x8*)(P.Q + qrow * D + hq * 64 + d0 * 16 + hi * 8);
        f32x16 o0, o1;
#pragma unroll
        for (int i = 0; i < 16; ++i) { o0[i] = 0.f; o1[i] = 0.f; }
        float carry = 1.f; bool active = true; int it = 0;
        for (int kt = qb; kt >= 0; --kt, ++it) {
            __syncthreads();
            if (it > 0) { if (flag[(it - 1) & 1] == 0u) break; }
            if (tid == 0) flag[it & 1] = 0u;
            *(LAS v4u*)(lds + AT_K + lr * AT_KLD + lc8 * 2) = kw;
            *(LAS v2u*)(lds + AT_V + lr * AT_VLD + lc8 * 2) = (v2u){vw.x, vw.y}; *(LAS v2u*)(lds + AT_V + lr * AT_VLD + lc8 * 2 + 8) = (v2u){vw.z, vw.w};
            if (kt > 0) { kw = *(const GAS v4u*)(kbase + (size_t)(kt - 1) * 64 * 256); vw = *(const GAS v4u*)(vbase + (kt - 1) * 64); }
            __syncthreads();
            if (active) {
                const bool diag = (kt == qb);
#pragma unroll
                for (int blk = 1; blk >= 0; --blk) {
                    if (diag && blk > half) continue;
                    f32x16 p;
#pragma unroll
                    for (int i = 0; i < 16; ++i) p[i] = 0.f;
#pragma unroll
                    for (int d0 = 0; d0 < 4; ++d0) { const bf16x8 kf = *(const LAS bf16x8*)(lds + AT_K + (blk * 32 + r32) * AT_KLD + (d0 * 16 + hi * 8) * 2);
                        p = __builtin_amdgcn_mfma_f32_32x32x16_bf16(kf, qr[d0], p, 0, 0, 0); }
                    unsigned pk[8];
                    if (diag && blk == half) sb_block<true>(p, carry, hi, r32, pk); else sb_block<false>(p, carry, hi, r32, pk);
#pragma unroll
                    for (int s = 0; s < 2; ++s) { const bf16x8 pf = __builtin_bit_cast(bf16x8, (v4u){pk[4 * s], pk[4 * s + 1], pk[4 * s + 2], pk[4 * s + 3]});
#pragma unroll
                        for (int db = 0; db < 2; ++db) { const LAS unsigned char* vp = lds + AT_V + (db * 32 + r32) * AT_VLD + (blk * 32 + 16 * s + 4 * hi) * 2;
                            const v2u lo = *(const LAS v2u*)vp, hh = *(const LAS v2u*)(vp + 16);
                            const bf16x8 vf = __builtin_bit_cast(bf16x8, (v4u){lo.x, lo.y, hh.x, hh.y});
                            if (db == 0) o0 = __builtin_amdgcn_mfma_f32_32x32x16_bf16(vf, pf, o0, 0, 0, 0); else o1 = __builtin_amdgcn_mfma_f32_32x32x16_bf16(vf, pf, o1, 0, 0, 0); } }
                }
                if (__any(carry > SB_LIVE)) { if (lane == 0) flag[it & 1] = 1u; } else active = false;
            }
        }
        bf16* op = P.O + qrow * D + hq * 64;
#pragma unroll
        for (int g = 0; g < 4; ++g) { v2u w0, w1; w0.x = cvtpk(o0[4 * g], o0[4 * g + 1]); w0.y = cvtpk(o0[4 * g + 2], o0[4 * g + 3]); w1.x = cvtpk(o1[4 * g], o1[4 * g + 1]); w1.y = cvtpk(o1[4 * g + 2], o1[4 * g + 3]);
            *(GAS v2u*)(op + 8 * g + 4 * hi) = w0; *(GAS v2u*)(op + 32 + 8 * g + 4 * hi) = w1; }
    }
    __syncthreads();
}

struct Args { const float* in[16]; float* out; unsigned char* ws; int ph_lo, ph_hi; };
__global__ void __launch_bounds__(NWAVES * 64, 2) yoco_fwd(Args args) {
    extern __shared__ __attribute__((aligned(16))) unsigned char lds[];
    Frame F;
    F.lds = (LAS unsigned char*)lds;
    F.MISC = (volatile LAS unsigned*)(F.lds + MISC_OFF);
    F.tid = threadIdx.x; F.lane = F.tid & 63; F.wave = __builtin_amdgcn_readfirstlane(F.tid >> 6);
    F.G = gridDim.x; { const int bx = blockIdx.x; F.vcu = (F.G % 8 == 0) ? (bx % 8) * (F.G / 8) + bx / 8 : bx; }
    unsigned char* ws = args.ws;
    F.ctl = (gu32*)(ws + WS_CTL);
    Ptrs P;
    P.x = args.in[0]; P.ffn_norm = args.in[1]; P.ffn_w_in = args.in[2]; P.ffn_w_out = args.in[3]; P.mix_norm = args.in[4]; P.a_w_in = args.in[5]; P.a_ln_g = args.in[6]; P.a_ln_b = args.in[7];
    P.a_w_s = args.in[8]; P.a_b_s = args.in[9]; P.a_w_out = args.in[10]; P.kv_norm = args.in[11]; P.w_kv = args.in[12]; P.b_w_q = args.in[13]; P.b_w_o = args.in[14]; P.final_norm = args.in[15];
    P.X = args.out;
    P.WIN = (bf16*)(ws + WS_WIN); P.WOUT = (bf16*)(ws + WS_WOUT); P.AIN = (bf16*)(ws + WS_AIN); P.AOUT = (bf16*)(ws + WS_AOUT); P.WQ = (bf16*)(ws + WS_WQ); P.WO = (bf16*)(ws + WS_WO);
    P.XB = (bf16*)(ws + WS_XB); P.H = (bf16*)(ws + WS_H); P.U = (bf16*)(ws + WS_H); P.UV = (bf16*)(ws + WS_UV); P.O = (bf16*)(ws + WS_H); P.VTs = (bf16*)(ws + WS_R2);
    P.Q = (bf16*)(ws + WS_R2); P.Kb = (bf16*)(ws + WS_R2 + 32 * MiB); P.VTa = (bf16*)(ws + WS_R2 + 40 * MiB);
    P.ssq = (float*)(ws + WS_CTL) + CW_SSQ; P.vsum = (float*)(ws + WS_CTL) + CW_VSUM; P.vsq = (float*)(ws + WS_CTL) + CW_VSQ;
    for (int u = F.tid; u < (LDS_BYTES - LDSCTL_OFF) / 4; u += NWAVES * 64) ((LAS unsigned*)(F.lds + LDSCTL_OFF))[u] = 0u;
    __syncthreads();
    XcdBarrier bar; bar.bar = (unsigned*)(F.ctl + CW_BAR); bar.x = 0; bar.st = nullptr;
#if !MK_PER_PHASE
    bar = xcd_barrier_post((unsigned*)(F.ctl + CW_BAR), F.MISC + 8);
#endif
    const int lo = args.ph_lo, hi = args.ph_hi;
#define IN(k) (lo <= (k) && (k) < hi)
#if MK_PER_PHASE
#define SEAM(k) do { } while (0)
#define SEAM_CG(k) do { } while (0)
#else
#define SEAM(k) do { if (IN(k) && IN((k) + 1)) xcd_barrier(bar); } while (0)
#define SEAM_CG(k) do { if (IN(k) && IN((k) + 1)) { asm volatile("s_waitcnt vmcnt(0)" ::: "memory"); __threadfence(); cg::this_grid().sync(); } } while (0)
#endif
    using pg8::Gemm; using pg8::StaticOrder;
    LAS unsigned char* ring = F.lds + RING_OFF;
    const int bid = (int)blockIdx.x;
#define WINp(mat) ((const pg8::bf16_t*)((const char*)P.WIN + (size_t)(mat) * WIN_STRIDE))
#define WOUTp(mat) ((const pg8::bf16_t*)((const char*)P.WOUT + (size_t)(mat) * WOUT_STRIDE))
#define FFN_IN(mat, nn, ssqi) do { Gemm g{(const pg8::bf16_t*)P.XB, WINp(mat), M, (nn), D}; StaticOrder S; S.init(M, (nn), F.G, bid); \
        pg8::EpiSwiglu E{(pg8::bf16_t*)P.H, P.ssq + (ssqi) * M, (pg8::bf16_t*)P.Kb, (pg8::bf16_t*)P.VTa, NIN_FFN / 256}; \
        pg8::gemm_phase<pg8::EpiSwiglu, StaticOrder, true, true>(ring, g, S, E); } while (0)
#define FFN_OUT(mat, F32, ssqo) do { Gemm g{(const pg8::bf16_t*)P.H, WOUTp(mat), M, D, DFF}; StaticOrder S; S.init(M, D, F.G, bid); \
        pg8::EpiResid<F32> E{P.x, (pg8::bf16_t*)P.XB, P.ssq + (ssqo) * M, 0.5f}; \
        pg8::gemm_phase<pg8::EpiResid<F32>, StaticOrder, true, true>(ring, g, S, E); } while (0)

    if (args.ph_hi > 1000) SEAM_CG(0);
    if (IN(0)) { p0_prologue(F, P); if (PROBE_PHASE == 0) p0_prologue(F, P); } SEAM(0);
    if (IN(1)) { FFN_IN(0, NIN_FFN, 0); if (PROBE_PHASE == 1) FFN_IN(0, NIN_FFN, 0); convert_batch(F, P, 1, (M / 256) * (NIN_FFN / 256)); } SEAM(1);
    if (IN(2)) { FFN_OUT(0, true, 1);
        if (PROBE_PHASE == 2) { Gemm g{(const pg8::bf16_t*)P.H, WOUTp(0), M, D, DFF}; StaticOrder S; S.init(M, D, F.G, bid);
            pg8::EpiResid<true> E{P.x, (pg8::bf16_t*)(ws + WS_R2), (float*)(ws + WS_CTL) + 196608, 0.5f};
            pg8::gemm_phase<pg8::EpiResid<true>, StaticOrder, true, true>(ring, g, S, E); } } SEAM(2);
    if (IN(3)) {
        { Gemm g{(const pg8::bf16_t*)P.XB, (const pg8::bf16_t*)P.AIN, M, DA, D}; StaticOrder S; S.init(M, DA, F.G, bid);
          pg8::EpiRowScale<1> E{(pg8::bf16_t*)P.U, DA, P.ssq + 1 * M, 1.0f};
          pg8::gemm_phase<pg8::EpiRowScale<1>, StaticOrder, true, true>(ring, g, S, E); }
        { Gemm g{(const pg8::bf16_t*)P.AIN + (size_t)DA * D, (const pg8::bf16_t*)P.XB, DA, M, D}; StaticOrder S; S.init(DA, M, F.G, bid);
          pg8::EpiGeluVT E{(pg8::bf16_t*)P.VTs, P.ssq + 1 * M, P.vsum, P.vsq};
          pg8::gemm_phase<pg8::EpiGeluVT, StaticOrder, true, true>(ring, g, S, E); }
    } SEAM(3);
    if (IN(4)) { sgu_phase(F, P); if (PROBE_PHASE == 4) sgu_phase(F, P); } SEAM(4);
    if (IN(5)) { Gemm g{(const pg8::bf16_t*)P.UV, (const pg8::bf16_t*)P.AOUT, M, D, DA}; StaticOrder S; S.init(M, D, F.G, bid);
        pg8::EpiResid<false> E{P.x, (pg8::bf16_t*)P.XB, P.ssq + 2 * M, 1.0f};
        pg8::gemm_phase<pg8::EpiResid<false>, StaticOrder, true, true>(ring, g, S, E); } SEAM(5);
    if (IN(6)) { FFN_IN(1, NIN_FFN, 2); convert_batch(F, P, 2, (M / 256) * (NIN_FFN / 256)); } SEAM(6);
    if (IN(7)) { FFN_OUT(1, false, 3); } SEAM(7);
    if (IN(8)) { FFN_IN(2, NIN_KV, 3); } SEAM(8);
    if (IN(9)) { FFN_OUT(2, false, 4); } SEAM(9);
    if (IN(10)) { Gemm g{(const pg8::bf16_t*)P.XB, (const pg8::bf16_t*)P.WQ, M, D, D}; StaticOrder S; S.init(M, D, F.G, bid);
        pg8::EpiRowScale<0> E{(pg8::bf16_t*)P.Q, D, P.ssq + 4 * M, 0.125f * 1.4426950409f};
        pg8::gemm_phase<pg8::EpiRowScale<0>, StaticOrder, true, true>(ring, g, S, E);
        if (PROBE_PHASE == 10) pg8::gemm_phase<pg8::EpiRowScale<0>, StaticOrder, true, true>(ring, g, S, E); } SEAM(10);
    if (IN(11)) { attn_phase(F, P); if (PROBE_PHASE == 11) attn_phase(F, P); } SEAM(11);
    if (IN(12)) { Gemm g{(const pg8::bf16_t*)P.O, (const pg8::bf16_t*)P.WO, M, D, D}; StaticOrder S; S.init(M, D, F.G, bid);
        pg8::EpiResid<false> E{P.x, (pg8::bf16_t*)P.XB, P.ssq + 5 * M, 1.0f};
        pg8::gemm_phase<pg8::EpiResid<false>, StaticOrder, true, true>(ring, g, S, E); } SEAM(12);
    if (IN(13)) { FFN_IN(3, NIN_FFN, 5); } SEAM(13);
    if (IN(14)) { FFN_OUT(3, false, 6); } SEAM(14);
    if (IN(15)) { final_norm_phase(F, P); }
#undef IN
}

extern "C" void kernel_launch(void* const* d_in, const int* in_sizes, int n_in, void* d_out, int out_size, void* d_ws, size_t ws_size, hipStream_t stream) {
    static int grid = 0;
    if (grid == 0) {
        if (n_in != 16 || in_sizes[0] != M * D || out_size != M * D || ws_size < WS_END) { fprintf(stderr, "kernel_launch: unexpected shapes / workspace (n_in %d, in0 %d, out %d, ws %zu); nothing launched\n", n_in, n_in > 0 ? in_sizes[0] : -1, out_size, ws_size); grid = -1; return; }
        int dev = 0, cus = 0, per_cu = 0;
        if (hipGetDevice(&dev) != hipSuccess || hipDeviceGetAttribute(&cus, hipDeviceAttributeMultiprocessorCount, dev) != hipSuccess) { grid = -1; return; }
        if (hipFuncSetAttribute((const void*)yoco_fwd, hipFuncAttributeMaxDynamicSharedMemorySize, LDS_BYTES) != hipSuccess) { fprintf(stderr, "kernel_launch: hipFuncSetAttribute failed\n"); grid = -1; return; }
        if (hipOccupancyMaxActiveBlocksPerMultiprocessor(&per_cu, (const void*)yoco_fwd, NWAVES * 64, LDS_BYTES) != hipSuccess || per_cu < 1) { fprintf(stderr, "kernel_launch: occupancy query says %d blocks per CU\n", per_cu); (void)hipGetLastError(); per_cu = 1; }
        grid = cus;
    }
    if (grid < 0) return;
    if (hipMemsetAsync((char*)d_ws + WS_CTL, 0, CTL_ZERO_BYTES, stream) != hipSuccess) { fprintf(stderr, "kernel_launch: hipMemsetAsync failed\n"); return; }
    Args a{};
    for (int i = 0; i < 16; ++i) a.in[i] = (const float*)d_in[i];
    a.out = (float*)d_out; a.ws = (unsigned char*)d_ws;
#if MK_PER_PHASE
    for (int ph = 0; ph < N_PHASES; ++ph) { a.ph_lo = ph; a.ph_hi = ph + 1; hipLaunchKernelGGL(yoco_fwd, dim3(grid), dim3(NWAVES * 64), LDS_BYTES, stream, a); }
#else
    a.ph_lo = 0; a.ph_hi = N_PHASES;
    void* kargs[] = {&a};
    const hipError_t e = hipLaunchCooperativeKernel((const void*)yoco_fwd, dim3(grid), dim3(NWAVES * 64), kargs, LDS_BYTES, stream);
    if (e != hipSuccess) fprintf(stderr, "kernel_launch: cooperative launch failed: %s (grid %d)\n", hipGetErrorString(e), grid);
#endif
}
```

```cpp
#include <hip/hip_runtime.h>
#include <hip/hip_cooperative_groups.h>
#include <cstdio>
#include <cstdint>
namespace cg = cooperative_groups;
namespace pg8 {
#define PG8_LAS __attribute__((address_space(3)))
typedef unsigned short bf16_t;
typedef short bf16x8 __attribute__((ext_vector_type(8)));
typedef float f32x4 __attribute__((ext_vector_type(4)));
typedef unsigned u32x4 __attribute__((ext_vector_type(4)));
constexpr int BM = 256, BK = 64, HALF = 128, HTB = HALF * BK * 2  , STAGE_BYTES = 8 * HTB, NXCD = 8, WGM = 8;

__host__ __device__ __forceinline__ int lds_byte(int r, int c) { const int st = (r >> 4) * 2 + (c >> 5), rr = r & 15, cc = c & 31, ob = rr * 64 + cc * 2; return st * 1024 + (ob ^ (((ob >> 9) & 1) << 5)); }
__host__ __device__ __forceinline__ void stage_rc(int b, int& R, int& C) { const int st = b / 1024, sb = b % 1024, swz = sb ^ (((sb >> 9) & 1) << 5); R = (st >> 1) * 16 + swz / 64; C = (st & 1) * 32 + (swz % 64) / 2; }
__host__ __device__ __forceinline__ int perm32(int rho) { const int n = rho >> 4, i = rho & 15; return 8 * (i >> 2) + 4 * n + (i & 3); }

struct Unit { int pm, pn; };
struct Gemm { const bf16_t* A; const bf16_t* Bt; int M, N, K; };

struct StaticOrder {
    int nM, nN, nwg, G, c;
    __host__ __device__ void init(int M, int N, int G_, int c_) { nM = M / BM; nN = N / BM; nwg = nM * nN; G = G_; c = c_; }
    __host__ __device__ bool next(int i, Unit& u) const {
        const long L = (long)i * G + c; if (L >= nwg) return false;
        int wgid = (int)L; { const int q = nwg / NXCD, r = nwg % NXCD, xcd = wgid % NXCD, off = wgid / NXCD; wgid = (xcd < r ? xcd * (q + 1) : r * (q + 1) + (xcd - r) * q) + off; }
        const int nig = WGM * nN, gid = wgid / nig, fm = gid * WGM, gsz = (nM - fm) < WGM ? (nM - fm) : WGM;
        u.pm = fm + ((wgid % nig) % gsz); u.pn = (wgid % nig) / gsz; return true;
    }
    __device__ __forceinline__ void a_ready(const Unit&) const {}
    __device__ __forceinline__ void done(const Unit&) const {}
};

__device__ __forceinline__ unsigned cvt_pk_bf16(float lo, float hi) { unsigned r; asm volatile("v_cvt_pk_bf16_f32 %0, %1, %2" : "=v"(r) : "v"(lo), "v"(hi)); return r; }
typedef float f32x2 __attribute__((ext_vector_type(2)));
constexpr int EM = 16384, ED = 1024, EFF = 2816, EDA = 2048, ESEQ = 4096;
constexpr float RMS_EPS = 1e-6f;
__device__ __forceinline__ float silu_mul(float g, float u) { return g * u * __builtin_amdgcn_rcpf(1.f + __builtin_amdgcn_exp2f(-1.4426950409f * g)); }
__device__ __forceinline__ float gelu_tanh(float x) { const float t = x * (2.3022081f + 0.10294324f * x * x); return x * __builtin_amdgcn_rcpf(1.f + __builtin_amdgcn_exp2f(-t)); }
__device__ __forceinline__ float rstd_of(const float* ssq, int row) { return __builtin_amdgcn_rsqf(ssq[row] * (1.0f / 1024.0f) + RMS_EPS); }
__device__ __forceinline__ unsigned short bf16_1(float v) { return (unsigned short)(cvt_pk_bf16(v, 0.f) & 0xffffu); }

struct EpiSwiglu {
    static constexpr bool PERM = true, AFTER_DRAIN = false;
    bf16_t* H; const float* ssq; bf16_t* Kb; bf16_t* VT; int nffn;
    __device__ __forceinline__ void operator()(const f32x4 (&acc)[2][2][4][2], const Unit& u, int wr, int wc, int fr, int fq) const {
        const int row0 = u.pm * BM + wr * 64 + fr;
        float rsv[2][4];
#pragma unroll
        for (int ai = 0; ai < 2; ++ai)
#pragma unroll
            for (int m = 0; m < 4; ++m) rsv[ai][m] = rstd_of(ssq, row0 + ai * HALF + m * 16);
        if (u.pn < nffn) {
            const int col0 = u.pn * 128 + wc * 32 + 8 * fq;
#pragma unroll
            for (int ai = 0; ai < 2; ++ai)
#pragma unroll
                for (int m = 0; m < 4; ++m) { const int row = row0 + ai * HALF + m * 16; const float rs = rsv[ai][m];
                    const f32x4 g0 = acc[ai][0][m][0] * rs, g1 = acc[ai][0][m][1] * rs, u0 = acc[ai][1][m][0] * rs, u1 = acc[ai][1][m][1] * rs;
                    u32x4 w; w.x = cvt_pk_bf16(silu_mul(g0[0], u0[0]), silu_mul(g0[1], u0[1])); w.y = cvt_pk_bf16(silu_mul(g0[2], u0[2]), silu_mul(g0[3], u0[3]));
                    w.z = cvt_pk_bf16(silu_mul(g1[0], u1[0]), silu_mul(g1[1], u1[1])); w.w = cvt_pk_bf16(silu_mul(g1[2], u1[2]), silu_mul(g1[3], u1[3]));
                    *(u32x4*)(H + (size_t)row * EFF + col0) = w; }
        } else {
            const int isv = u.pn - nffn;
#pragma unroll
            for (int ai = 0; ai < 2; ++ai)
#pragma unroll
                for (int m = 0; m < 4; ++m) { const int row = row0 + ai * HALF + m * 16; const float rs = rsv[ai][m];
#pragma unroll
                    for (int bj = 0; bj < 2; ++bj) { const int col = bj * HALF + wc * 32 + 8 * fq; const f32x4 v0 = acc[ai][bj][m][0] * rs, v1 = acc[ai][bj][m][1] * rs;
                        if (isv == 0) { u32x4 w; w.x = cvt_pk_bf16(v0[0], v0[1]); w.y = cvt_pk_bf16(v0[2], v0[3]); w.z = cvt_pk_bf16(v1[0], v1[1]); w.w = cvt_pk_bf16(v1[2], v1[3]);
                            *(u32x4*)(Kb + (size_t)row * 256 + col) = w; }
                        else { const int b = row >> 12, s = row & (ESEQ - 1), kvh = col >> 6, d0 = col & 63;
                            bf16_t* p = VT + ((size_t)((b * 4 + kvh) * 64 + d0)) * ESEQ + s;
#pragma unroll
                            for (int e = 0; e < 4; ++e) { p[(size_t)e * ESEQ] = bf16_1(v0[e]); p[(size_t)(e + 4) * ESEQ] = bf16_1(v1[e]); } } } }
        }
    }
};
__device__ __forceinline__ float bf_lo(unsigned w) { return __uint_as_float(w << 16); }
__device__ __forceinline__ float bf_hi(unsigned w) { return __uint_as_float(w & 0xffff0000u); }
template <bool SRC_F32> struct EpiResid {
    static constexpr bool PERM = true, AFTER_DRAIN = false;
    const float* src32; bf16_t* xb; float* ssq_out; float scale;
    __device__ __forceinline__ void operator()(const f32x4 (&acc)[2][2][4][2], const Unit& u, int wr, int wc, int fr, int fq) const {
        const int row0 = u.pm * BM + wr * 64 + fr, col0 = u.pn * BM + wc * 32 + 8 * fq;
        u32x4 rr[2][4][2];
        if (!SRC_F32) {
#pragma unroll
            for (int ai = 0; ai < 2; ++ai)
#pragma unroll
                for (int m = 0; m < 4; ++m)
#pragma unroll
                    for (int bj = 0; bj < 2; ++bj) rr[ai][m][bj] = *(const u32x4*)(xb + (size_t)(row0 + ai * HALF + m * 16) * ED + col0 + bj * HALF);
        }
#pragma unroll
        for (int ai = 0; ai < 2; ++ai)
#pragma unroll
            for (int m = 0; m < 4; ++m) { const int row = row0 + ai * HALF + m * 16; float ss = 0.f;
#pragma unroll
                for (int bj = 0; bj < 2; ++bj) { const size_t off = (size_t)row * ED + col0 + bj * HALF;
                    f32x4 a0, a1;
                    if (SRC_F32) { a0 = *(const f32x4*)(src32 + off); a1 = *(const f32x4*)(src32 + off + 4); }
                    else { const u32x4 r = rr[ai][m][bj]; a0 = (f32x4){bf_lo(r.x), bf_hi(r.x), bf_lo(r.y), bf_hi(r.y)}; a1 = (f32x4){bf_lo(r.z), bf_hi(r.z), bf_lo(r.w), bf_hi(r.w)}; }
                    const f32x4 v0 = a0 + acc[ai][bj][m][0] * scale, v1 = a1 + acc[ai][bj][m][1] * scale;
                    ss += (v0[0] * v0[0] + v0[1] * v0[1]) + (v0[2] * v0[2] + v0[3] * v0[3]) + (v1[0] * v1[0] + v1[1] * v1[1]) + (v1[2] * v1[2] + v1[3] * v1[3]);
                    u32x4 w; w.x = cvt_pk_bf16(v0[0], v0[1]); w.y = cvt_pk_bf16(v0[2], v0[3]); w.z = cvt_pk_bf16(v1[0], v1[1]); w.w = cvt_pk_bf16(v1[2], v1[3]);
                    *(u32x4*)(xb + off) = w; }
                ss += __shfl_xor(ss, 16); ss += __shfl_xor(ss, 32);
                if (fq == 0) unsafeAtomicAdd(ssq_out + row, ss);
                if (SRC_F32 && (m & 1)) asm volatile("" ::: "memory"); }
    }
};
template <int ACT> struct EpiRowScale {
    static constexpr bool PERM = true, AFTER_DRAIN = false;
    bf16_t* O; int ldc; const float* ssq; float oscale;
    __device__ __forceinline__ void operator()(const f32x4 (&acc)[2][2][4][2], const Unit& u, int wr, int wc, int fr, int fq) const {
        const int row0 = u.pm * BM + wr * 64 + fr, col0 = u.pn * BM + wc * 32 + 8 * fq;
        float rsv[2][4];
#pragma unroll
        for (int ai = 0; ai < 2; ++ai)
#pragma unroll
            for (int m = 0; m < 4; ++m) rsv[ai][m] = rstd_of(ssq, row0 + ai * HALF + m * 16);
#pragma unroll
        for (int ai = 0; ai < 2; ++ai)
#pragma unroll
            for (int m = 0; m < 4; ++m) { const int row = row0 + ai * HALF + m * 16; const float rs = rsv[ai][m];
#pragma unroll
                for (int bj = 0; bj < 2; ++bj) { f32x4 v0 = acc[ai][bj][m][0] * rs, v1 = acc[ai][bj][m][1] * rs;
                    if (ACT == 1) {
#pragma unroll
                        for (int e = 0; e < 4; ++e) { v0[e] = gelu_tanh(v0[e]); v1[e] = gelu_tanh(v1[e]); } }
                    v0 = v0 * oscale; v1 = v1 * oscale;
                    u32x4 w; w.x = cvt_pk_bf16(v0[0], v0[1]); w.y = cvt_pk_bf16(v0[2], v0[3]); w.z = cvt_pk_bf16(v1[0], v1[1]); w.w = cvt_pk_bf16(v1[2], v1[3]);
                    *(u32x4*)(O + (size_t)row * ldc + col0 + bj * HALF) = w; } }
    }
};
struct EpiGeluVT {
    static constexpr bool PERM = true, AFTER_DRAIN = false;
    bf16_t* VT; const float* ssq; float* vsum; float* vsq;
    __device__ __forceinline__ void operator()(const f32x4 (&acc)[2][2][4][2], const Unit& u, int wr, int wc, int fr, int fq) const {
        const int row0 = u.pm * BM + wr * 64 + fr, col0 = u.pn * BM + wc * 32 + 8 * fq;
#pragma unroll
        for (int bj = 0; bj < 2; ++bj) {
            float rs[8], cs[8], cq[8];
#pragma unroll
            for (int e = 0; e < 8; ++e) { rs[e] = rstd_of(ssq, col0 + bj * HALF + e); cs[e] = 0.f; cq[e] = 0.f; }
#pragma unroll
            for (int ai = 0; ai < 2; ++ai)
#pragma unroll
                for (int m = 0; m < 4; ++m) { const int row = row0 + ai * HALF + m * 16; float v[8];
#pragma unroll
                    for (int e = 0; e < 4; ++e) { v[e] = gelu_tanh(acc[ai][bj][m][0][e] * rs[e]); v[e + 4] = gelu_tanh(acc[ai][bj][m][1][e] * rs[e + 4]); }
#pragma unroll
                    for (int e = 0; e < 8; ++e) { cs[e] += v[e]; cq[e] += v[e] * v[e]; }
                    u32x4 w; w.x = cvt_pk_bf16(v[0], v[1]); w.y = cvt_pk_bf16(v[2], v[3]); w.z = cvt_pk_bf16(v[4], v[5]); w.w = cvt_pk_bf16(v[6], v[7]);
                    *(u32x4*)(VT + (size_t)row * EM + col0 + bj * HALF) = w; }
#pragma unroll
            for (int e = 0; e < 8; ++e) {
#pragma unroll
                for (int o = 1; o < 16; o <<= 1) { cs[e] += __shfl_xor(cs[e], o); cq[e] += __shfl_xor(cq[e], o); } }
            if (fr == 0) {
#pragma unroll
                for (int e = 0; e < 8; ++e) { unsafeAtomicAdd(vsum + col0 + bj * HALF + e, cs[e]); unsafeAtomicAdd(vsq + col0 + bj * HALF + e, cq[e]); } }
        }
    }
};

template <class Epi, class Sched, bool ALIGN_EPI = false, bool SP2 = false>
__device__ __forceinline__ void gemm_phase(PG8_LAS unsigned char* lds, const Gemm g, const Sched& S, const Epi& E) {
    const int tid = threadIdx.x, wid = __builtin_amdgcn_readfirstlane(tid >> 6), lane = tid & 63, wr = wid >> 2, wc = wid & 3, fr = lane & 15, fq = lane >> 4;
    const int K = g.K, nt = K / BK;
    unsigned voffA[2], voffB[2];
#pragma unroll
    for (int i = 0; i < 2; ++i) { int R, C; stage_rc(tid * 16 + i * 8192, R, C); const int Rb = Epi::PERM ? ((R & ~31) + perm32(R & 31)) : R;
        voffA[i] = (unsigned)(R * K + C) * 2u; voffB[i] = (unsigned)(Rb * K + C) * 2u; }
    const size_t kstep = (size_t)(BK * 2);
    const size_t hstep = (size_t)HALF * K * 2;
    const size_t tstep = 2 * hstep;
    const unsigned ldsw = (unsigned)wid * 1024u;
    const int aoff = lds_byte(wr * 64 + fr, fq * 8), boff = lds_byte(wc * 32 + fr, fq * 8);
#define PG8_SA(b, h) (((b) * 2 + (h)) * HTB)
#define PG8_SB(b, h) ((4 + (b) * 2 + (h)) * HTB)
#define PG8_STAGE(bufoff, gbase, voff) do { _Pragma("unroll") for (int _i = 0; _i < 2; ++_i) \
        __builtin_amdgcn_global_load_lds((const unsigned*)((const char*)(gbase) + (voff)[_i]), (PG8_LAS unsigned*)(lds + (bufoff) + ldsw + _i * 8192), 16, 0, 0); } while (0)
#define PG8_LDA(dst, b, h) do { _Pragma("unroll") for (int m = 0; m < 4; ++m) _Pragma("unroll") for (int k = 0; k < 2; ++k) dst[m][k] = *(const PG8_LAS bf16x8*)(lds + PG8_SA(b, h) + aoff + m * 2048 + k * 1024); } while (0)
#define PG8_LDB(dst, b, h) do { _Pragma("unroll") for (int n = 0; n < 2; ++n) _Pragma("unroll") for (int k = 0; k < 2; ++k) dst[n][k] = *(const PG8_LAS bf16x8*)(lds + PG8_SB(b, h) + boff + n * 2048 + k * 1024); } while (0)
#define PG8_MMA(ai, bj, At, Bt) do { __builtin_amdgcn_s_setprio(1); _Pragma("unroll") for (int m = 0; m < 4; ++m) _Pragma("unroll") for (int n = 0; n < 2; ++n) _Pragma("unroll") for (int k = 0; k < 2; ++k) \
        acc[ai][bj][m][n] = __builtin_amdgcn_mfma_f32_16x16x32_bf16(Bt[n][k], At[m][k], acc[ai][bj][m][n], 0, 0, 0); __builtin_amdgcn_s_setprio(0); } while (0)
#define PG8_WAIT_V(n) asm volatile("s_waitcnt vmcnt(" #n ")" ::: "memory")
#define PG8_WAIT_L(n) asm volatile("s_waitcnt lgkmcnt(" #n ")" ::: "memory")
#define PG8_BAR __builtin_amdgcn_s_barrier()
#define PG8_SCHED __builtin_amdgcn_sched_barrier(0)
    Unit cur, nxt; int ui = 0;
    if (!S.next(0, cur)) return;
    f32x4 acc[2][2][4][2];
#pragma unroll
    for (int a = 0; a < 2; ++a)
#pragma unroll
        for (int b = 0; b < 2; ++b)
#pragma unroll
            for (int m = 0; m < 4; ++m)
#pragma unroll
                for (int n = 0; n < 2; ++n) acc[a][b][m][n] = (f32x4){0.f, 0.f, 0.f, 0.f};
    bf16x8 At[4][2], B0[2][2], B1[2][2];
    const char* cA = (const char*)g.A + (size_t)cur.pm * tstep; const char* cB = (const char*)g.Bt + (size_t)cur.pn * tstep;
    S.a_ready(cur);
    if constexpr (SP2) {
        PG8_STAGE(PG8_SB(0, 0), cB, voffB); PG8_STAGE(PG8_SB(0, 1), cB + hstep, voffB); PG8_STAGE(PG8_SA(0, 0), cA, voffA); PG8_STAGE(PG8_SA(0, 1), cA + hstep, voffA);
        if (wr == 1) PG8_BAR;
        PG8_WAIT_V(2); PG8_BAR;
        PG8_STAGE(PG8_SB(1, 0), cB + kstep, voffB); PG8_STAGE(PG8_SA(1, 0), cA + kstep, voffA); PG8_STAGE(PG8_SB(1, 1), cB + hstep + kstep, voffB);
        PG8_WAIT_V(6); PG8_BAR;
    } else {
        PG8_STAGE(PG8_SB(0, 0), cB, voffB); PG8_STAGE(PG8_SA(0, 0), cA, voffA); PG8_STAGE(PG8_SB(0, 1), cB + hstep, voffB); PG8_STAGE(PG8_SA(0, 1), cA + hstep, voffA);
        if (wr == 1) PG8_BAR;
        PG8_WAIT_V(4); PG8_BAR;
        PG8_STAGE(PG8_SB(1, 0), cB + kstep, voffB); PG8_STAGE(PG8_SA(1, 0), cA + kstep, voffA); PG8_STAGE(PG8_SB(1, 1), cB + hstep + kstep, voffB);
        PG8_WAIT_V(6); PG8_BAR;
    }
    for (;;) {
        const bool has_next = S.next(ui + 1, nxt);
        const char* nA = has_next ? (const char*)g.A + (size_t)nxt.pm * tstep : cA; const char* nB = has_next ? (const char*)g.Bt + (size_t)nxt.pn * tstep : cB;
        for (int t = 0; t < nt; t += 2) {
            const bool last = (t == nt - 2);
            const char* a1 = cA + (size_t)(t + 1) * kstep;
            const char* a2 = last ? nA : cA + (size_t)(t + 2) * kstep; const char* b2 = last ? nB : cB + (size_t)(t + 2) * kstep;
            const char* a3 = a2 + kstep; const char* b3 = b2 + kstep;
            if (last && has_next) S.a_ready(nxt);
            if constexpr (SP2) {
            PG8_LDB(B0, 0, 0); PG8_LDB(B1, 0, 1); PG8_SCHED; PG8_LDA(At, 0, 0); PG8_STAGE(PG8_SA(1, 1), a1 + hstep, voffA);
            PG8_WAIT_V(8); PG8_WAIT_L(0); PG8_BAR; PG8_MMA(0, 0, At, B0); PG8_MMA(0, 1, At, B1); PG8_BAR; PG8_SCHED;
            PG8_LDA(At, 0, 1); PG8_STAGE(PG8_SB(0, 0), b2, voffB); PG8_STAGE(PG8_SB(0, 1), b2 + hstep, voffB); PG8_STAGE(PG8_SA(0, 0), a2, voffA);
            PG8_WAIT_V(8); PG8_WAIT_L(0); PG8_BAR; PG8_MMA(1, 0, At, B0); PG8_MMA(1, 1, At, B1); PG8_BAR; PG8_SCHED;
            PG8_LDB(B0, 1, 0); PG8_LDB(B1, 1, 1); PG8_SCHED; PG8_LDA(At, 1, 0); PG8_STAGE(PG8_SA(0, 1), a2 + hstep, voffA);
            PG8_WAIT_V(8); PG8_WAIT_L(0); PG8_BAR; PG8_MMA(0, 0, At, B0); PG8_MMA(0, 1, At, B1); PG8_BAR; PG8_SCHED;
            PG8_LDA(At, 1, 1); PG8_STAGE(PG8_SB(1, 0), b3, voffB); PG8_STAGE(PG8_SB(1, 1), b3 + hstep, voffB); PG8_STAGE(PG8_SA(1, 0), a3, voffA);
            PG8_WAIT_V(8); PG8_WAIT_L(0); PG8_BAR; PG8_MMA(1, 0, At, B0); PG8_MMA(1, 1, At, B1); PG8_BAR; PG8_SCHED;
            } else {
            PG8_LDB(B0, 0, 0); PG8_SCHED; PG8_LDA(At, 0, 0); PG8_STAGE(PG8_SA(1, 1), a1 + hstep, voffA);
            PG8_WAIT_L(8); PG8_BAR; PG8_WAIT_L(0); PG8_MMA(0, 0, At, B0); PG8_BAR; PG8_SCHED;
            PG8_LDB(B1, 0, 1); PG8_STAGE(PG8_SB(0, 0), b2, voffB);
            PG8_BAR; PG8_WAIT_L(0); PG8_MMA(0, 1, At, B1); PG8_BAR;
            PG8_LDA(At, 0, 1); PG8_STAGE(PG8_SA(0, 0), a2, voffA);
            PG8_BAR; PG8_WAIT_L(0); PG8_MMA(1, 0, At, B0); PG8_BAR; PG8_SCHED;
            PG8_STAGE(PG8_SB(0, 1), b2 + hstep, voffB);
            PG8_WAIT_V(6); PG8_BAR; PG8_MMA(1, 1, At, B1); PG8_BAR;
            PG8_LDB(B0, 1, 0); PG8_SCHED; PG8_LDA(At, 1, 0); PG8_STAGE(PG8_SA(0, 1), a2 + hstep, voffA);
            PG8_WAIT_L(8); PG8_BAR; PG8_WAIT_L(0); PG8_MMA(0, 0, At, B0); PG8_BAR; PG8_SCHED;
            PG8_LDB(B1, 1, 1); PG8_STAGE(PG8_SB(1, 0), b3, voffB);
            PG8_BAR; PG8_WAIT_L(0); PG8_MMA(0, 1, At, B1); PG8_BAR;
            PG8_LDA(At, 1, 1); PG8_STAGE(PG8_SA(1, 0), a3, voffA);
            PG8_BAR; PG8_WAIT_L(0); PG8_MMA(1, 0, At, B0); PG8_BAR; PG8_SCHED;
            PG8_STAGE(PG8_SB(1, 1), b3 + hstep, voffB);
            PG8_WAIT_V(6); PG8_BAR; PG8_MMA(1, 1, At, B1); PG8_BAR;
            }
        }
        if constexpr (ALIGN_EPI) { if (wr == 0) PG8_BAR; }
        if constexpr (!Epi::AFTER_DRAIN) { E(acc, cur, wr, wc, fr, fq); S.done(cur); }
        if (!has_next) break;
#pragma unroll
        for (int a = 0; a < 2; ++a)
#pragma unroll
            for (int b = 0; b < 2; ++b)
#pragma unroll
                for (int m = 0; m < 4; ++m)
#pragma unroll
                    for (int n = 0; n < 2; ++n) acc[a][b][m][n] = (f32x4){0.f, 0.f, 0.f, 0.f};
        cur = nxt; cA = nA; cB = nB; ++ui;
        if constexpr (ALIGN_EPI) { if (wr == 1) PG8_BAR; }
    }
    PG8_WAIT_V(0);
    if constexpr (!ALIGN_EPI) { if (wr == 0) PG8_BAR; }
    PG8_BAR;
    if constexpr (Epi::AFTER_DRAIN) { E.fused(acc, cur, wr, wc, fr, fq, lds, wid, lane); S.done(cur); }
#undef PG8_SA
#undef PG8_SB
#undef PG8_STAGE
#undef PG8_LDA
#undef PG8_LDB
#undef PG8_MMA
#undef PG8_WAIT_V
#undef PG8_WAIT_L
#undef PG8_BAR
#undef PG8_SCHED
}
}
constexpr int NWAVES = 8;
constexpr int M = 16384, D = 1024, DFF = 2816, DA = 2048, SEQ = 4096, NBATCH = 4;
constexpr int NIN_FFN = 2 * DFF;
constexpr int NIN_KV = NIN_FFN + 512;
#ifndef MK_PER_PHASE
#define MK_PER_PHASE 0
#endif
constexpr int N_PHASES = 16;
#ifndef PROBE_PHASE
#define PROBE_PHASE -1
#endif

constexpr size_t MiB = 1u << 20;
constexpr size_t WS_CTL = 0, CTL_ZERO_BYTES = 1 * MiB;
constexpr size_t WS_WIN = 2 * MiB;
constexpr size_t WIN_STRIDE = 12 * MiB;
constexpr size_t WS_WOUT = WS_WIN + 4 * WIN_STRIDE;
constexpr size_t WOUT_STRIDE = 6 * MiB;
constexpr size_t WS_AIN = WS_WOUT + 4 * WOUT_STRIDE;
constexpr size_t WS_AOUT = WS_AIN + 8 * MiB;
constexpr size_t WS_WQ = WS_AOUT + 4 * MiB;
constexpr size_t WS_WO = WS_WQ + 2 * MiB;
constexpr size_t WS_XB = WS_WO + 2 * MiB;
constexpr size_t WS_H = WS_XB + 32 * MiB;
constexpr size_t WS_R2 = WS_H + 88 * MiB;
constexpr size_t WS_UV = WS_R2 + 64 * MiB;
constexpr size_t WS_END = WS_UV + 64 * MiB;
constexpr int CW_BAR = 4096;
constexpr int CW_SSQ = 16384;
constexpr int CW_VSUM = CW_SSQ + 7 * M, CW_VSQ = CW_VSUM + M;
static_assert((size_t)(CW_VSQ + M) * 4 <= CTL_ZERO_BYTES, "CTL words inside the memset region");

constexpr int RING_OFF = 0, RING_BYTES = 131072;
constexpr int LDSCTL_OFF = RING_BYTES, MISC_OFF = LDSCTL_OFF + 320;
constexpr int LDS_BYTES = 147456;

#define GAS __attribute__((address_space(1)))
#define LAS __attribute__((address_space(3)))
typedef unsigned short bf16;
typedef unsigned v4u __attribute__((ext_vector_type(4)));
typedef float f32x4 __attribute__((ext_vector_type(4)));
typedef short bf16x8 __attribute__((ext_vector_type(8)));
typedef GAS unsigned gu32;
typedef GAS unsigned long long gu64;
#define RLX_AGENT __ATOMIC_RELAXED, __HIP_MEMORY_SCOPE_AGENT
#define LDS_WAIT() asm volatile("s_waitcnt lgkmcnt(0)" ::: "memory")
#define VM_WAIT() asm volatile("s_waitcnt vmcnt(0)" ::: "memory")
__device__ __forceinline__ unsigned long long rt() { return __builtin_amdgcn_s_memrealtime(); }
__device__ __forceinline__ unsigned f2bf(float f) { unsigned u = __builtin_bit_cast(unsigned, f); return (u + 0x7fffu + ((u >> 16) & 1u)) >> 16; }
__device__ __forceinline__ unsigned pk2(float lo, float hi) { return f2bf(lo) | (f2bf(hi) << 16); }

#define XB_TMO      128
#define XB_XCNT(j)  (256  + 64 * (j))
#define XB_XSUB(j)  (1280 + 64 * (j))
#define XB_XGEN(j)  (2304 + 64 * (j))
#define XB_TOP      3328
#define XB_TOPGEN   3392
#define XCD_BAR_WORDS 3456
#define XB_SPIN_CAP (1u << 18)

__device__ __forceinline__ unsigned xb_ld(unsigned* p)              { return __hip_atomic_load(p, __ATOMIC_RELAXED, __HIP_MEMORY_SCOPE_AGENT); }
__device__ __forceinline__ unsigned xb_add(unsigned* p, unsigned v) { return __hip_atomic_fetch_add(p, v, __ATOMIC_RELAXED, __HIP_MEMORY_SCOPE_AGENT); }
__device__ __forceinline__ unsigned xb_xcc_id() { return (unsigned)__builtin_amdgcn_s_getreg((3 << 11) | 20) & 0xFu; }
#define XB_SPIN(cond, bar) do { unsigned _sp = 0; while (cond) { __builtin_amdgcn_s_sleep(1); \
    if ((++_sp & 255u) == 0u) { if (xb_ld(&(bar)[XB_TMO])) break; if (_sp > XB_SPIN_CAP) { atomicAdd(&(bar)[XB_TMO], 1u); break; } } } } while (0)

struct XcdBarrier {
    unsigned* bar; unsigned x;
    volatile LAS unsigned* st;
};

__device__ __forceinline__ XcdBarrier xcd_barrier_post(unsigned* bar, volatile LAS unsigned* st) {
    XcdBarrier b; b.bar = bar; b.x = xb_xcc_id(); b.st = st;
    if (threadIdx.x == 0) (void)xb_add(&bar[XB_XCNT(b.x)], 1u);
    return b;
}
__device__ __forceinline__ void xcd_barrier_complete(unsigned* bar, unsigned x, unsigned& nloc, unsigned& nx) {
    const unsigned G = gridDim.x * gridDim.y * gridDim.z;
    unsigned sum, cnt, mine, sp = 0u;
    for (;;) {
        sum = 0u; cnt = 0u; mine = 0u;
#pragma unroll
        for (unsigned j = 0; j < 16; ++j) { const unsigned c = xb_ld(&bar[XB_XCNT(j)]); sum += c; cnt += (c > 0u) ? 1u : 0u; mine = (j == x) ? c : mine; }
        if (sum == G) break;
        __builtin_amdgcn_s_sleep(1);
        if ((++sp & 255u) == 0u) { if (xb_ld(&bar[XB_TMO])) break; if (sp > XB_SPIN_CAP) { atomicAdd(&bar[XB_TMO], 1u); break; } }
    }
    nloc = mine > 0u ? mine : 1u; nx = cnt > 0u ? cnt : 1u;
}

__device__ __forceinline__ void xcd_barrier(const XcdBarrier& b) {
    asm volatile("s_waitcnt vmcnt(0)" ::: "memory");
    __syncthreads();
    if (threadIdx.x == 0) {
        unsigned* bar = b.bar;
        __builtin_amdgcn_s_waitcnt(0);
        unsigned nloc = b.st[0], nx = b.st[1];
        if (nloc == 0u) { xcd_barrier_complete(bar, b.x, nloc, nx); b.st[0] = nloc; b.st[1] = nx; }
        const unsigned old = xb_add(&bar[XB_XSUB(b.x)], 1u);
        const unsigned gen = old / nloc;
        if (old + 1u == (gen + 1u) * nloc) {
            __builtin_amdgcn_fence(__ATOMIC_RELEASE, "agent");
            asm volatile("s_waitcnt vmcnt(0)" ::: "memory");
            const unsigned og = xb_add(&bar[XB_TOP], 1u);
            const unsigned tg = og / nx;
            if (og + 1u == (tg + 1u) * nx) xb_add(&bar[XB_TOPGEN], 1u);
            else XB_SPIN(xb_ld(&bar[XB_TOPGEN]) == tg, bar);
            __builtin_amdgcn_fence(__ATOMIC_ACQUIRE, "agent");
            xb_add(&bar[XB_XGEN(b.x)], 1u);
            asm volatile("s_waitcnt vmcnt(0)" ::: "memory");
        } else {
            XB_SPIN(xb_ld(&bar[XB_XGEN(b.x)]) == gen, bar);
            __builtin_amdgcn_fence(__ATOMIC_ACQUIRE, "agent");
            asm volatile("s_waitcnt vmcnt(0)" ::: "memory");
        }
    }
    __syncthreads();
}
typedef float f32x16 __attribute__((ext_vector_type(16)));
typedef short s16x4 __attribute__((ext_vector_type(4)));
typedef unsigned v2u __attribute__((ext_vector_type(2)));
typedef float f32x2_t __attribute__((ext_vector_type(2))); typedef __bf16 bf16x2_t __attribute__((ext_vector_type(2)));
__device__ __forceinline__ unsigned cvtpk(float lo, float hi) { f32x2_t v = {lo, hi}; bf16x2_t b = __builtin_convertvector(v, bf16x2_t); return __builtin_bit_cast(unsigned, b); }
__device__ __forceinline__ float bflo(unsigned w) { return __uint_as_float(w << 16); }
__device__ __forceinline__ float bfhi(unsigned w) { return __uint_as_float(w & 0xffff0000u); }

struct Frame {
    LAS unsigned char* lds;
    volatile LAS unsigned* MISC;
    gu32* ctl;
    int tid, lane, wave;
    int vcu, G;
};
__device__ __forceinline__ float wave_sum(float v) {
#pragma unroll
    for (int o = 1; o < 64; o <<= 1) v += __shfl_xor(v, o);
    return v;
}
__device__ __forceinline__ void p0_item(const float* W, int ldn, int K, int nblk, bf16* WT, const float* gk, int mode, LAS float* scr, int item, int lane) {
    const int kb = item / nblk, nb = item % nblk, k0 = 64 * kb, n0 = 32 * nb;
    const int rowb = (mode == 0) ? n0 : (256 * (n0 >> 7) + (n0 & 127) + (mode == 2 ? 128 : 0));
    const int kr = lane >> 3, n4 = (lane & 7) * 4;
    f32x4 w[8];
#pragma unroll
    for (int i = 0; i < 8; ++i) w[i] = *(const GAS f32x4*)(W + (size_t)(k0 + i * 8 + kr) * ldn + n0 + n4);
    if (gk) {
#pragma unroll
        for (int i = 0; i < 8; ++i) w[i] = w[i] * gk[k0 + i * 8 + kr]; }
#pragma unroll
    for (int i = 0; i < 8; ++i) { LAS float* d = scr + (i * 8 + kr) * 33 + n4; d[0] = w[i].x; d[1] = w[i].y; d[2] = w[i].z; d[3] = w[i].w; }
    LDS_WAIT(); asm volatile("" ::: "memory");
    const int c = lane & 7;
#pragma unroll
    for (int j = 0; j < 4; ++j) { const int n = (lane >> 3) + 8 * j; const LAS float* s = scr + (8 * c) * 33 + n;
        v4u o; o.x = pk2(s[0 * 33], s[1 * 33]); o.y = pk2(s[2 * 33], s[3 * 33]); o.z = pk2(s[4 * 33], s[5 * 33]); o.w = pk2(s[6 * 33], s[7 * 33]);
        *(GAS v4u*)(WT + (size_t)(rowb + n) * K + k0 + 8 * c) = o; }
    LDS_WAIT(); asm volatile("" ::: "memory");
}
struct Ptrs {
    const float *x, *ffn_norm, *ffn_w_in, *ffn_w_out, *mix_norm, *a_w_in, *a_ln_g, *a_ln_b, *a_w_s, *a_b_s, *a_w_out, *kv_norm, *w_kv, *b_w_q, *b_w_o, *final_norm;
    float* X;
    bf16 *WIN, *WOUT, *AIN, *AOUT, *WQ, *WO, *XB, *H, *U, *UV, *O, *VTs, *Q, *Kb, *VTa;
    float *ssq, *vsum, *vsq;
};
constexpr int I_IN = 16 * (DFF / 32);
constexpr int I_KV = 16 * (512 / 32);
constexpr int I_OUT = (DFF / 64) * (D / 32);
constexpr int I_AIN = 16 * (2 * DA / 32);
constexpr int I_AOUT = (DA / 64) * (D / 32);
constexpr int I_Q = 16 * 32;
constexpr int IT_KV = 8 * I_IN, IT_OUT = IT_KV + I_KV, IT_AIN = IT_OUT + 4 * I_OUT, IT_AOUT = IT_AIN + I_AIN, IT_Q = IT_AOUT + I_AOUT, IT_O = IT_Q + I_Q, NITEMS = IT_O + I_Q;
__device__ __forceinline__ void convert_one(const Ptrs& P, LAS float* scr, int it, int lane) {
    int r = it;
    if (r < 8 * I_IN) { const int mat = r / (2 * I_IN), rr = r % (2 * I_IN), up = rr / I_IN, item = rr % I_IN;
        p0_item(P.ffn_w_in + (size_t)mat * D * NIN_FFN + up * DFF, NIN_FFN, D, DFF / 32, (bf16*)((char*)P.WIN + mat * WIN_STRIDE), P.ffn_norm + mat * D, 1 + up, scr, item, lane); return; }
    r -= 8 * I_IN;
    if (r < I_KV) { p0_item(P.w_kv, 512, D, 16, (bf16*)((char*)P.WIN + 2 * WIN_STRIDE) + (size_t)NIN_FFN * D, P.kv_norm, 0, scr, r, lane); return; }
    r -= I_KV;
    if (r < 4 * I_OUT) { const int mat = r / I_OUT, item = r % I_OUT;
        p0_item(P.ffn_w_out + (size_t)mat * DFF * D, D, DFF, D / 32, (bf16*)((char*)P.WOUT + mat * WOUT_STRIDE), nullptr, 0, scr, item, lane); return; }
    r -= 4 * I_OUT;
    if (r < I_AIN) { p0_item(P.a_w_in, 2 * DA, D, 2 * DA / 32, P.AIN, P.mix_norm, 0, scr, r, lane); return; }
    r -= I_AIN;
    if (r < I_AOUT) { p0_item(P.a_w_out, D, DA, D / 32, P.AOUT, nullptr, 0, scr, r, lane); return; }
    r -= I_AOUT;
    if (r < I_Q) { p0_item(P.b_w_q, D, D, D / 32, P.WQ, P.mix_norm + D, 0, scr, r, lane); return; }
    r -= I_Q;
    p0_item(P.b_w_o, D, D, D / 32, P.WO, nullptr, 0, scr, r, lane);
}
__device__ __forceinline__ void convert_batch(Frame& F, const Ptrs& P, int batch, int nunits) {
    const int G = F.G, bid = (int)blockIdx.x, rounds = (nunits + G - 1) / G, first_short = nunits - (rounds - 1) * G;
    int nshort = G - first_short, sidx = bid - first_short;
    if (nshort == 0) { nshort = G; sidx = bid; }
    if (sidx < 0) return;
    LAS float* scr = (LAS float*)(F.lds + RING_OFF + F.wave * 16384);
    const int n = batch == 1 ? (2 * I_IN + 2 * I_OUT + I_AIN + I_AOUT) : (batch == 2 ? (4 * I_IN + I_KV + I_OUT + 2 * I_Q) : I_OUT);
    for (int j = sidx * NWAVES + F.wave; j < n; j += nshort * NWAVES) {
        int it;
        if (batch == 1) it = j < 2 * I_IN ? 2 * I_IN + j : (j < 2 * I_IN + 2 * I_OUT ? IT_OUT + (j - 2 * I_IN) : IT_AIN + (j - 2 * I_IN - 2 * I_OUT));
        else if (batch == 2) it = j < 4 * I_IN + I_KV ? 4 * I_IN + j : (j < 4 * I_IN + I_KV + I_OUT ? IT_OUT + 2 * I_OUT + (j - 4 * I_IN - I_KV) : IT_Q + (j - 4 * I_IN - I_KV - I_OUT));
        else it = IT_OUT + 3 * I_OUT + j;
        convert_one(P, scr, it, F.lane);
    }
}
__device__ __forceinline__ void p0_prologue(Frame& F, const Ptrs& P) {
    LAS float* scr = (LAS float*)(F.lds + RING_OFF + F.wave * 16384);
    const int gw = F.vcu * NWAVES + F.wave, NGW = F.G * NWAVES;
    for (int it = gw; it < 2 * I_IN; it += NGW) convert_one(P, scr, it, F.lane);
    for (int m = gw; m < M; m += NGW) {
        const GAS f32x4* xr = (const GAS f32x4*)(P.x + (size_t)m * D) + F.lane;
        f32x4 v[4]; float s = 0.f;
#pragma unroll
        for (int j = 0; j < 4; ++j) { v[j] = xr[64 * j]; s += (v[j].x * v[j].x + v[j].y * v[j].y) + (v[j].z * v[j].z + v[j].w * v[j].w); }
        s = wave_sum(s);
        GAS unsigned long long* o8 = (GAS unsigned long long*)(P.XB + (size_t)m * D) + F.lane;
#pragma unroll
        for (int j = 0; j < 4; ++j) o8[64 * j] = (unsigned long long)pk2(v[j].x, v[j].y) | ((unsigned long long)pk2(v[j].z, v[j].w) << 32);
        if (F.lane == 0) P.ssq[m] = s;
    }
}
__device__ __forceinline__ void final_norm_phase(Frame& F, const Ptrs& P) {
    const int gw = F.vcu * NWAVES + F.wave, NGW = F.G * NWAVES;
    f32x4 g0[2], g1[2];
#pragma unroll
    for (int j = 0; j < 2; ++j) { g0[j] = ((const GAS f32x4*)P.final_norm)[2 * F.lane + 128 * j]; g1[j] = ((const GAS f32x4*)P.final_norm)[2 * F.lane + 128 * j + 1]; }
    for (int m = gw; m < M; m += NGW) {
        const float rs = __builtin_amdgcn_rsqf(P.ssq[6 * M + m] * (1.0f / 1024.0f) + 1e-6f);
#pragma unroll
        for (int j = 0; j < 2; ++j) { const v4u r = ((const GAS v4u*)(P.XB + (size_t)m * D))[F.lane + 64 * j];
            GAS f32x4* o = (GAS f32x4*)(P.X + (size_t)m * D) + 2 * F.lane + 128 * j;
            o[0] = (f32x4){bflo(r.x), bfhi(r.x), bflo(r.y), bfhi(r.y)} * rs * g0[j]; o[1] = (f32x4){bflo(r.z), bfhi(r.z), bflo(r.w), bfhi(r.w)} * rs * g1[j]; }
    }
}

constexpr int SG_WM = 0, SG_LD = 272, SG_BT = 128 * SG_LD  , SG_CLD = 528, SG_STAT = SG_BT + 256 * SG_LD  ;
static_assert(128 * SG_CLD <= 256 * SG_LD && SG_STAT + 1024 <= RING_BYTES, "sgu LDS map");
__device__ __forceinline__ void sgu_phase(Frame& F, const Ptrs& P) {
    LAS unsigned char* lds = F.lds + RING_OFF;
    const int tid = F.tid, lane = F.lane, wid = F.wave, fr = lane & 15, fq = lane >> 4, wt = wid >> 2, wc = wid & 3;
    const int s8 = (tid & 15) * 8, crow0 = tid >> 4;
    int gload = -1;
    v4u vraw[8]; float st_sum = 0.f, st_sq = 0.f;
#define SG_PREFETCH(unx) do { const int g_ = (unx) & 7, tok_ = ((unx) >> 3) * 128; \
        _Pragma("unroll") for (int i = 0; i < 8; ++i) vraw[i] = *(const GAS v4u*)(P.VTs + (size_t)(g_ * 256 + i * 32 + crow0) * M + tok_ + s8); \
        if (tid < 128) { st_sum = P.vsum[tok_ + tid]; st_sq = P.vsq[tok_ + tid]; } } while (0)
    if (F.vcu < 1024) SG_PREFETCH(F.vcu);
    for (int un = F.vcu; un < 1024; un += F.G) {
        const int g = un & 7, chunk = un >> 3, tok0 = chunk * 128;
        __syncthreads();
        if (g != gload) {
            const float* ws = P.a_w_s + (size_t)g * 128 * 128;
#pragma unroll
            for (int i = 0; i < 4; ++i) { const int idx = i * 512 + tid, t = idx >> 4, sb = (idx & 15) * 8;
                const f32x4 a = *(const GAS f32x4*)(ws + t * 128 + sb), b = *(const GAS f32x4*)(ws + t * 128 + sb + 4);
                float v[8] = {a.x, a.y, a.z, a.w, b.x, b.y, b.z, b.w};
#pragma unroll
                for (int e = 0; e < 8; ++e) v[e] = (sb + e <= t) ? v[e] : 0.f;
                v4u o; o.x = cvtpk(v[0], v[1]); o.y = cvtpk(v[2], v[3]); o.z = cvtpk(v[4], v[5]); o.w = cvtpk(v[6], v[7]);
                *(LAS v4u*)(lds + SG_WM + t * SG_LD + sb * 2) = o; }
            gload = g;
        }
        if (tid < 128) { const float mean = st_sum * (1.0f / 2048.0f); const float var = fmaxf(st_sq * (1.0f / 2048.0f) - mean * mean, 0.f);
            ((LAS float*)(lds + SG_STAT))[tid] = mean; ((LAS float*)(lds + SG_STAT))[128 + tid] = __builtin_amdgcn_rsqf(var + 1e-5f); }
        __syncthreads();
        {
            float mu[8], rsd[8];
#pragma unroll
            for (int e = 0; e < 8; ++e) { mu[e] = ((LAS float*)(lds + SG_STAT))[s8 + e]; rsd[e] = ((LAS float*)(lds + SG_STAT))[128 + s8 + e]; }
#pragma unroll
            for (int i = 0; i < 8; ++i) { const int c = i * 32 + crow0, cgl = g * 256 + c;
                const v4u w = vraw[i]; const float lg = P.a_ln_g[cgl], lb = P.a_ln_b[cgl];
                float v[8] = {bflo(w.x), bfhi(w.x), bflo(w.y), bfhi(w.y), bflo(w.z), bfhi(w.z), bflo(w.w), bfhi(w.w)};
#pragma unroll
                for (int e = 0; e < 8; ++e) v[e] = (v[e] - mu[e]) * rsd[e] * lg + lb;
                v4u o; o.x = cvtpk(v[0], v[1]); o.y = cvtpk(v[2], v[3]); o.z = cvtpk(v[4], v[5]); o.w = cvtpk(v[6], v[7]);
                *(LAS v4u*)(lds + SG_BT + c * SG_LD + s8 * 2) = o; }
        }
        __syncthreads();
        v4u ureg[8];
#pragma unroll
        for (int i = 0; i < 8; ++i) { const int idx = i * 512 + tid, t = idx >> 5, c8 = (idx & 31) * 8; ureg[i] = *(const GAS v4u*)(P.U + (size_t)(tok0 + t) * DA + g * 256 + c8); }
        if (un + F.G < 1024) SG_PREFETCH(un + F.G);
        f32x4 acc[4][4];
#pragma unroll
        for (int a = 0; a < 4; ++a)
#pragma unroll
            for (int b = 0; b < 4; ++b) acc[a][b] = (f32x4){0.f, 0.f, 0.f, 0.f};
#pragma unroll
        for (int ks = 0; ks < 4; ++ks) { bf16x8 af[4], bfr[4];
#pragma unroll
            for (int i = 0; i < 4; ++i) { af[i] = *(const LAS bf16x8*)(lds + SG_WM + (wt * 64 + i * 16 + fr) * SG_LD + (ks * 32 + fq * 8) * 2);
                                          bfr[i] = *(const LAS bf16x8*)(lds + SG_BT + (wc * 64 + i * 16 + fr) * SG_LD + (ks * 32 + fq * 8) * 2); }
#pragma unroll
            for (int mt = 0; mt < 4; ++mt)
#pragma unroll
                for (int nt = 0; nt < 4; ++nt) acc[mt][nt] = __builtin_amdgcn_mfma_f32_16x16x32_bf16(bfr[nt], af[mt], acc[mt][nt], 0, 0, 0); }
        __syncthreads();
#pragma unroll
        for (int mt = 0; mt < 4; ++mt) { const int t = wt * 64 + mt * 16 + fr; const float bs = P.a_b_s[g * 128 + t];
#pragma unroll
            for (int nt = 0; nt < 4; ++nt) { const int c = wc * 64 + nt * 16 + 4 * fq; const f32x4 v = acc[mt][nt] + bs;
                v2u o; o.x = cvtpk(v[0], v[1]); o.y = cvtpk(v[2], v[3]); *(LAS v2u*)(lds + SG_BT + t * SG_CLD + c * 2) = o; } }
        __syncthreads();
#pragma unroll
        for (int i = 0; i < 8; ++i) { const int idx = i * 512 + tid, t = idx >> 5, c8 = (idx & 31) * 8;
            const v4u cw = *(const LAS v4u*)(lds + SG_BT + t * SG_CLD + c8 * 2); const v4u uw = ureg[i];
            v4u o; o.x = cvtpk(bflo(cw.x) * bflo(uw.x), bfhi(cw.x) * bfhi(uw.x)); o.y = cvtpk(bflo(cw.y) * bflo(uw.y), bfhi(cw.y) * bfhi(uw.y));
            o.z = cvtpk(bflo(cw.z) * bflo(uw.z), bfhi(cw.z) * bfhi(uw.z)); o.w = cvtpk(bflo(cw.w) * bflo(uw.w), bfhi(cw.w) * bfhi(uw.w));
            *(GAS v4u*)(P.UV + (size_t)(tok0 + t) * DA + g * 256 + c8) = o; }
    }
#undef SG_PREFETCH
    __syncthreads();
}

constexpr int AT_K = 0, AT_KLD = 144, AT_V = 64 * AT_KLD  , AT_VLD = 136, AT_FLAG = AT_V + 64 * AT_VLD  ;
constexpr float SB_LIVE = 1.0e-43f;
__device__ __forceinline__ int crow(int r, int hi) { return (r & 3) + 8 * (r >> 2) + 4 * hi; }
template <bool MASKED> __device__ __forceinline__ void sb_block(f32x16& p, float& carry, int hi, int qloc, unsigned (&pk)[8]) {
    float om[16];
#pragma unroll
    for (int i = 0; i < 16; ++i) { om[i] = __builtin_amdgcn_rcpf(1.f + __builtin_amdgcn_exp2f(p[i])); if (MASKED) { if (!(crow(i, hi) < qloc)) om[i] = 1.f; } }
    float gp[4], pg[4];
#pragma unroll
    for (int g = 0; g < 4; ++g) gp[g] = (om[4 * g] * om[4 * g + 1]) * (om[4 * g + 2] * om[4 * g + 3]);
#pragma unroll
    for (int g = 0; g < 4; ++g) pg[g] = __shfl_xor(gp[g], 32);
    const float t0 = gp[0] * pg[0], t1 = gp[1] * pg[1], t2 = gp[2] * pg[2], t3 = gp[3] * pg[3];
    float above[4]; above[3] = 1.f; above[2] = t3; above[1] = t3 * t2; above[0] = above[1] * t1;
    const float total = above[0] * t0;
#pragma unroll
    for (int g = 0; g < 4; ++g) { float c = carry * above[g] * (hi == 0 ? pg[g] : 1.f);
#pragma unroll
        for (int e = 3; e >= 0; --e) { const int i = 4 * g + e; p[i] = (1.f - om[i]) * c; c *= om[i]; } }
    carry *= total;
#pragma unroll
    for (int j = 0; j < 8; ++j) pk[j] = cvtpk(p[2 * j], p[2 * j + 1]);
}
__device__ __forceinline__ void attn_phase(Frame& F, const Ptrs& P) {
    LAS unsigned char* lds = F.lds + RING_OFF;
    volatile LAS unsigned* flag = (volatile LAS unsigned*)(lds + AT_FLAG);
    const int tid = F.tid, lane = F.lane, wid = F.wave, r32 = lane & 31, hi = lane >> 5, half = wid & 1;
    const int lr = tid >> 3, lc8 = (tid & 7) * 8;
    for (int un = F.vcu; un < 1024; un += F.G) {
        const int bk = un & 15, qb = un >> 4, b = bk >> 2, kvh = bk & 3, hq = kvh * 4 + (wid >> 1);
        const size_t qrow = (size_t)b * SEQ + qb * 64 + half * 32 + r32;
        const bf16* kbase = P.Kb + ((size_t)b * SEQ + lr) * 256 + kvh * 64 + lc8;
        const bf16* vbase = P.VTa + ((size_t)(bk * 64 + lr)) * SEQ + lc8;
        v4u kw = *(const GAS v4u*)(kbase + (size_t)qb * 64 * 256), vw = *(const GAS v4u*)(vbase + qb * 64);
        bf16x8 qr[4];
#pragma unroll
        for (int d0 = 0; d0 < 4; ++d0) qr[d0] = *(const GAS bf16x8*)(P.Q + qrow * D + hq * 64 + d0 * 16 + hi * 8);
        f32x16 o0, o1;
#pragma unroll
        for (int i = 0; i < 16; ++i) { o0[i] = 0.f; o1[i] = 0.f; }
        float carry = 1.f; bool active = true; int it = 0;
        for (int kt = qb; kt >= 0; --kt, ++it) {
            __syncthreads();
            if (it > 0) { if (flag[(it - 1) & 1] == 0u) break; }
            if (tid == 0) flag[it & 1] = 0u;
            *(LAS v4u*)(lds + AT_K + lr * AT_KLD + lc8 * 2) = kw;
            *(LAS v2u*)(lds + AT_V + lr * AT_VLD + lc8 * 2) = (v2u){vw.x, vw.y}; *(LAS v2u*)(lds + AT_V + lr * AT_VLD + lc8 * 2 + 8) = (v2u){vw.z, vw.w};
            if (kt > 0) { kw = *(const GAS v4u*)(kbase + (size_t)(kt - 1) * 64 * 256); vw = *(const GAS v4u*)(vbase + (kt - 1) * 64); }
            __syncthreads();
            if (active) {
                const bool diag = (kt == qb);
#pragma unroll
                for (int blk = 1; blk >= 0; --blk) {
                    if (diag && blk > half) continue;
                    f32x16 p;
#pragma unroll
                    for (int i = 0; i < 16; ++i) p[i] = 0.f;
#pragma unroll
                    for (int d0 = 0; d0 < 4; ++d0) { const bf16x8 kf = *(const LAS bf16x8*)(lds + AT_K + (blk * 32 + r32) * AT_KLD + (d0 * 16 + hi * 8) * 2);
                        p = __builtin_amdgcn_mfma_f32_32x32x16_bf16(kf, qr[d0], p, 0, 0, 0); }
                    unsigned pk[8];
                    if (diag && blk == half) sb_block<true>(p, carry, hi, r32, pk); else sb_block<false>(p, carry, hi, r32, pk);
#pragma unroll
                    for (int s = 0; s < 2; ++s) { const bf16x8 pf = __builtin_bit_cast(bf16x8, (v4u){pk[4 * s], pk[4 * s + 1], pk[4 * s + 2], pk[4 * s + 3]});
#pragma unroll
                        for (int db = 0; db < 2; ++db) { const LAS unsigned char* vp = lds + AT_V + (db * 32 + r32) * AT_VLD + (blk * 32 + 16 * s + 4 * hi) * 2;
                            const v2u lo = *(const LAS v2u*)vp, hh = *(const LAS v2u*)(vp + 16);
                            const bf16x8 vf = __builtin_bit_cast(bf16x8, (v4u){lo.x, lo.y, hh.x, hh.y});
                            if (db == 0) o0 = __builtin_amdgcn_mfma_f32_32x32x16_bf16(vf, pf, o0, 0, 0, 0); else o1 = __builtin_amdgcn_mfma_f32_32x32x16_bf16(vf, pf, o1, 0, 0, 0); } }
                }
                if (__any(carry > SB_LIVE)) { if (lane == 0) flag[it & 1] = 1u; } else active = false;
            }
        }
        bf16* op = P.O + qrow * D + hq * 64;
#pragma unroll
        for (int g = 0; g < 4; ++g) { v2u w0, w1; w0.x = cvtpk(o0[4 * g], o0[4 * g + 1]); w0.y = cvtpk(o0[4 * g + 2], o0[4 * g + 3]); w1.x = cvtpk(o1[4 * g], o1[4 * g + 1]); w1.y = cvtpk(o1[4 * g + 2], o1[4 * g + 3]);
            *(GAS v2u*)(op + 8 * g + 4 * hi) = w0; *(GAS v2u*)(op + 32 + 8 * g + 4 * hi) = w1; }
    }
    __syncthreads();
}

struct Args { const float* in[16]; float* out; unsigned char* ws; int ph_lo, ph_hi; };
__global__ void __launch_bounds__(NWAVES * 64, 2) yoco_fwd(Args args) {
    extern __shared__ __attribute__((aligned(16))) unsigned char lds[];
    Frame F;
    F.lds = (LAS unsigned char*)lds;
    F.MISC = (volatile LAS unsigned*)(F.lds + MISC_OFF);
    F.tid = threadIdx.x; F.lane = F.tid & 63; F.wave = __builtin_amdgcn_readfirstlane(F.tid >> 6);
    F.G = gridDim.x; { const int bx = blockIdx.x; F.vcu = (F.G % 8 == 0) ? (bx % 8) * (F.G / 8) + bx / 8 : bx; }
    unsigned char* ws = args.ws;
    F.ctl = (gu32*)(ws + WS_CTL);
    Ptrs P;
    P.x = args.in[0]; P.ffn_norm = args.in[1]; P.ffn_w_in = args.in[2]; P.ffn_w_out = args.in[3]; P.mix_norm = args.in[4]; P.a_w_in = args.in[5]; P.a_ln_g = args.in[6]; P.a_ln_b = args.in[7];
    P.a_w_s = args.in[8]; P.a_b_s = args.in[9]; P.a_w_out = args.in[10]; P.kv_norm = args.in[11]; P.w_kv = args.in[12]; P.b_w_q = args.in[13]; P.b_w_o = args.in[14]; P.final_norm = args.in[15];
    P.X = args.out;
    P.WIN = (bf16*)(ws + WS_WIN); P.WOUT = (bf16*)(ws + WS_WOUT); P.AIN = (bf16*)(ws + WS_AIN); P.AOUT = (bf16*)(ws + WS_AOUT); P.WQ = (bf16*)(ws + WS_WQ); P.WO = (bf16*)(ws + WS_WO);
    P.XB = (bf16*)(ws + WS_XB); P.H = (bf16*)(ws + WS_H); P.U = (bf16*)(ws + WS_H); P.UV = (bf16*)(ws + WS_UV); P.O = (bf16*)(ws + WS_H); P.VTs = (bf16*)(ws + WS_R2);
    P.Q = (bf16*)(ws + WS_R2); P.Kb = (bf16*)(ws + WS_R2 + 32 * MiB); P.VTa = (bf16*)(ws + WS_R2 + 40 * MiB);
    P.ssq = (float*)(ws + WS_CTL) + CW_SSQ; P.vsum = (float*)(ws + WS_CTL) + CW_VSUM; P.vsq = (float*)(ws + WS_CTL) + CW_VSQ;
    for (int u = F.tid; u < (LDS_BYTES - LDSCTL_OFF) / 4; u += NWAVES * 64) ((LAS unsigned*)(F.lds + LDSCTL_OFF))[u] = 0u;
    __syncthreads();
    XcdBarrier bar; bar.bar = (unsigned*)(F.ctl + CW_BAR); bar.x = 0; bar.st = nullptr;
#if !MK_PER_PHASE
    bar = xcd_barrier_post((unsigned*)(F.ctl + CW_BAR), F.MISC + 8);
#endif
    const int lo = args.ph_lo, hi = args.ph_hi;
#define IN(k) (lo <= (k) && (k) < hi)
#if MK_PER_PHASE
#define SEAM(k) do { } while (0)
#define SEAM_CG(k) do { } while (0)
#else
#define SEAM(k) do { if (IN(k) && IN((k) + 1)) { xcd_barrier(bar); if (PROBE_PHASE == 99) xcd_barrier(bar); } } while (0)
#define SEAM_CG(k) do { if (IN(k) && IN((k) + 1)) { asm volatile("s_waitcnt vmcnt(0)" ::: "memory"); __threadfence(); cg::this_grid().sync(); } } while (0)
#endif
    using pg8::Gemm; using pg8::StaticOrder;
    LAS unsigned char* ring = F.lds + RING_OFF;
    const int bid = (int)blockIdx.x;
#define WINp(mat) ((const pg8::bf16_t*)((const char*)P.WIN + (size_t)(mat) * WIN_STRIDE))
#define WOUTp(mat) ((const pg8::bf16_t*)((const char*)P.WOUT + (size_t)(mat) * WOUT_STRIDE))
#define FFN_IN(mat, nn, ssqi) do { Gemm g{(const pg8::bf16_t*)P.XB, WINp(mat), M, (nn), D}; StaticOrder S; S.init(M, (nn), F.G, bid); \
        pg8::EpiSwiglu E{(pg8::bf16_t*)P.H, P.ssq + (ssqi) * M, (pg8::bf16_t*)P.Kb, (pg8::bf16_t*)P.VTa, NIN_FFN / 256}; \
        pg8::gemm_phase<pg8::EpiSwiglu, StaticOrder, true, true>(ring, g, S, E); } while (0)
#define FFN_OUT(mat, F32, ssqo) do { Gemm g{(const pg8::bf16_t*)P.H, WOUTp(mat), M, D, DFF}; StaticOrder S; S.init(M, D, F.G, bid); \
        pg8::EpiResid<F32> E{P.x, (pg8::bf16_t*)P.XB, P.ssq + (ssqo) * M, 0.5f}; \
        pg8::gemm_phase<pg8::EpiResid<F32>, StaticOrder, true, true>(ring, g, S, E); } while (0)

    if (args.ph_hi > 1000) SEAM_CG(0);
    if (IN(0)) { p0_prologue(F, P); if (PROBE_PHASE == 0) p0_prologue(F, P); } SEAM(0);
    if (IN(1)) { FFN_IN(0, NIN_FFN, 0); if (PROBE_PHASE == 1) FFN_IN(0, NIN_FFN, 0); convert_batch(F, P, 1, (M / 256) * (NIN_FFN / 256)); } SEAM(1);
    if (IN(2)) { FFN_OUT(0, true, 1);
        if (PROBE_PHASE == 2) { Gemm g{(const pg8::bf16_t*)P.H, WOUTp(0), M, D, DFF}; StaticOrder S; S.init(M, D, F.G, bid);
            pg8::EpiResid<true> E{P.x, (pg8::bf16_t*)(ws + WS_R2), (float*)(ws + WS_CTL) + 196608, 0.5f};
            pg8::gemm_phase<pg8::EpiResid<true>, StaticOrder, true, true>(ring, g, S, E); } } SEAM(2);
    if (IN(3)) {
        { Gemm g{(const pg8::bf16_t*)P.XB, (const pg8::bf16_t*)P.AIN, M, DA, D}; StaticOrder S; S.init(M, DA, F.G, bid);
          pg8::EpiRowScale<1> E{(pg8::bf16_t*)P.U, DA, P.ssq + 1 * M, 1.0f};
          pg8::gemm_phase<pg8::EpiRowScale<1>, StaticOrder, true, true>(ring, g, S, E); }
        { Gemm g{(const pg8::bf16_t*)P.AIN + (size_t)DA * D, (const pg8::bf16_t*)P.XB, DA, M, D}; StaticOrder S; S.init(DA, M, F.G, bid);
          pg8::EpiGeluVT E{(pg8::bf16_t*)P.VTs, P.ssq + 1 * M, P.vsum, P.vsq};
          pg8::gemm_phase<pg8::EpiGeluVT, StaticOrder, true, true>(ring, g, S, E); }
    } SEAM(3);
    if (IN(4)) { sgu_phase(F, P); if (PROBE_PHASE == 4) sgu_phase(F, P); } SEAM(4);
    if (IN(5)) { Gemm g{(const pg8::bf16_t*)P.UV, (const pg8::bf16_t*)P.AOUT, M, D, DA}; StaticOrder S; S.init(M, D, F.G, bid);
        pg8::EpiResid<false> E{P.x, (pg8::bf16_t*)P.XB, P.ssq + 2 * M, 1.0f};
        pg8::gemm_phase<pg8::EpiResid<false>, StaticOrder, true, true>(ring, g, S, E); } SEAM(5);
    if (IN(6)) { FFN_IN(1, NIN_FFN, 2); convert_batch(F, P, 2, (M / 256) * (NIN_FFN / 256)); } SEAM(6);
    if (IN(7)) { FFN_OUT(1, false, 3); } SEAM(7);
    if (IN(8)) { FFN_IN(2, NIN_KV, 3); } SEAM(8);
    if (IN(9)) { FFN_OUT(2, false, 4); } SEAM(9);
    if (IN(10)) { Gemm g{(const pg8::bf16_t*)P.XB, (const pg8::bf16_t*)P.WQ, M, D, D}; StaticOrder S; S.init(M, D, F.G, bid);
        pg8::EpiRowScale<0> E{(pg8::bf16_t*)P.Q, D, P.ssq + 4 * M, 0.125f * 1.4426950409f};
        pg8::gemm_phase<pg8::EpiRowScale<0>, StaticOrder, true, true>(ring, g, S, E);
        if (PROBE_PHASE == 10) pg8::gemm_phase<pg8::EpiRowScale<0>, StaticOrder, true, true>(ring, g, S, E); } SEAM(10);
    if (IN(11)) { attn_phase(F, P); if (PROBE_PHASE == 11) attn_phase(F, P); } SEAM(11);
    if (IN(12)) { Gemm g{(const pg8::bf16_t*)P.O, (const pg8::bf16_t*)P.WO, M, D, D}; StaticOrder S; S.init(M, D, F.G, bid);
        pg8::EpiResid<false> E{P.x, (pg8::bf16_t*)P.XB, P.ssq + 5 * M, 1.0f};
        pg8::gemm_phase<pg8::EpiResid<false>, StaticOrder, true, true>(ring, g, S, E); } SEAM(12);
    if (IN(13)) { FFN_IN(3, NIN_FFN, 5); convert_batch(F, P, 3, (M / 256) * (NIN_FFN / 256)); } SEAM(13);
    if (IN(14)) { FFN_OUT(3, false, 6); } SEAM(14);
    if (IN(15)) { final_norm_phase(F, P); }
#undef IN
}

extern "C" void kernel_launch(void* const* d_in, const int* in_sizes, int n_in, void* d_out, int out_size, void* d_ws, size_t ws_size, hipStream_t stream) {
    static int grid = 0;
    if (grid == 0) {
        if (n_in != 16 || in_sizes[0] != M * D || out_size != M * D || ws_size < WS_END) { fprintf(stderr, "kernel_launch: unexpected shapes / workspace (n_in %d, in0 %d, out %d, ws %zu); nothing launched\n", n_in, n_in > 0 ? in_sizes[0] : -1, out_size, ws_size); grid = -1; return; }
        int dev = 0, cus = 0, per_cu = 0;
        if (hipGetDevice(&dev) != hipSuccess || hipDeviceGetAttribute(&cus, hipDeviceAttributeMultiprocessorCount, dev) != hipSuccess) { grid = -1; return; }
        if (hipFuncSetAttribute((const void*)yoco_fwd, hipFuncAttributeMaxDynamicSharedMemorySize, LDS_BYTES) != hipSuccess) { fprintf(stderr, "kernel_launch: hipFuncSetAttribute failed\n"); grid = -1; return; }
        if (hipOccupancyMaxActiveBlocksPerMultiprocessor(&per_cu, (const void*)yoco_fwd, NWAVES * 64, LDS_BYTES) != hipSuccess || per_cu < 1) { fprintf(stderr, "kernel_launch: occupancy query says %d blocks per CU\n", per_cu); (void)hipGetLastError(); per_cu = 1; }
        grid = cus;
    }
    if (grid < 0) return;
    if (hipMemsetAsync((char*)d_ws + WS_CTL, 0, CTL_ZERO_BYTES, stream) != hipSuccess) { fprintf(stderr, "kernel_launch: hipMemsetAsync failed\n"); return; }
    Args a{};
    for (int i = 0; i < 16; ++i) a.in[i] = (const float*)d_in[i];
    a.out = (float*)d_out; a.ws = (unsigned char*)d_ws;
#if MK_PER_PHASE
    for (int ph = 0; ph < N_PHASES; ++ph) { a.ph_lo = ph; a.ph_hi = ph + 1; hipLaunchKernelGGL(yoco_fwd, dim3(grid), dim3(NWAVES * 64), LDS_BYTES, stream, a); }
#else
    a.ph_lo = 0; a.ph_hi = N_PHASES;
    void* kargs[] = {&a};
    const hipError_t e = hipLaunchCooperativeKernel((const void*)yoco_fwd, dim3(grid), dim3(NWAVES * 64), kargs, LDS_BYTES, stream);
    if (e != hipSuccess) fprintf(stderr, "kernel_launch: cooperative launch failed: %s (grid %d)\n", hipGetErrorString(e), grid);
#endif
}
```
